# Optimizing an MI355X kernel written in HIP

```python
import math
import jax, jax.numpy as jnp
from jax import lax
import numpy as np

D_MODEL = 1024
BATCH = 1
SEQ = 16384
DEPTH = 1
DEC_BATCH = 8
DEC_SEQ = 32
PAST_LEN = 1024

CHUNK = 64
S5_WIDTH = D_MODEL // 2
S5_GROUP = 16
S5_GROUPS = S5_WIDTH // S5_GROUP
S5_STATE = 64
GM_WIDTH = D_MODEL // 2
GM_CHUNK = 128
GM_HEADS = 8
GM_HEAD_DIM = GM_WIDTH // GM_HEADS
MIX_WIDTH = S5_WIDTH + GM_WIDTH
IN_WIDTH = S5_WIDTH + 2 * GM_WIDTH
D_FF = -(-8 * D_MODEL // (3 * 256)) * 256
N_MOD = 6
EPS = 1e-6

kernel_name = 'hymba_s5_gmlp_adaln_stream_step'


def rmsnorm(x, g):
    xf = x.astype(jnp.float32)
    y = xf * lax.rsqrt(jnp.mean(xf * xf, axis=-1, keepdims=True) + EPS)
    return (y * g.astype(jnp.float32)).astype(x.dtype)


def layernorm(x, g, b):
    xf = x.astype(jnp.float32)
    mu = jnp.mean(xf, axis=-1, keepdims=True)
    var = jnp.mean(jnp.square(xf - mu), axis=-1, keepdims=True)
    y = (xf - mu) * lax.rsqrt(var + EPS)
    return (y * g.astype(jnp.float32) + b.astype(jnp.float32)).astype(x.dtype)


def _scan_combine(e1, e2):
    a1r, a1i, b1r, b1i = e1
    a2r, a2i, b2r, b2i = e2
    return (a2r * a1r - a2i * a1i,
            a2r * a1i + a2i * a1r,
            a2r * b1r - a2i * b1i + b2r,
            a2r * b1i + a2i * b1r + b2i)


def s5_mixer(u, x0_re, x0_im, lam_re, lam_im, log_step, b_re, b_im, c_re, c_im, d):
    f32 = jnp.float32
    bsz, seq, _ = u.shape
    uf = u.astype(f32).reshape(bsz, seq, S5_GROUPS, S5_GROUP)
    lr = lam_re.astype(f32)
    li = lam_im.astype(f32)
    step = jnp.exp(log_step.astype(f32))[:, None]
    mag = jnp.exp(lr * step)
    ab_re = mag * jnp.cos(li * step)
    ab_im = mag * jnp.sin(li * step)
    den = lr * lr + li * li
    f_re = ((ab_re - 1.0) * lr + ab_im * li) / den
    f_im = (ab_im * lr - (ab_re - 1.0) * li) / den
    br = b_re.astype(f32)
    bi = b_im.astype(f32)
    bb_re = f_re[..., None] * br - f_im[..., None] * bi
    bb_im = f_re[..., None] * bi + f_im[..., None] * br
    bu_re = jnp.einsum('blgp,gnp->blgn', uf, bb_re)
    bu_im = jnp.einsum('blgp,gnp->blgn', uf, bb_im)
    x0r = x0_re.astype(f32)
    x0i = x0_im.astype(f32)
    bu_re = bu_re.at[:, 0].add(ab_re * x0r - ab_im * x0i)
    bu_im = bu_im.at[:, 0].add(ab_re * x0i + ab_im * x0r)
    a_re = jnp.broadcast_to(ab_re, bu_re.shape)
    a_im = jnp.broadcast_to(ab_im, bu_im.shape)
    _, _, s_re, s_im = lax.associative_scan(_scan_combine, (a_re, a_im, bu_re, bu_im), axis=1)
    y = (jnp.einsum('blgn,gpn->blgp', s_re, c_re.astype(f32))
         - jnp.einsum('blgn,gpn->blgp', s_im, c_im.astype(f32))
         + d.astype(f32) * uf)
    return (y.reshape(bsz, seq, S5_WIDTH).astype(u.dtype),
            s_re[:, -1].astype(u.dtype), s_im[:, -1].astype(u.dtype))


def gmlp_mixer(u, v, w_s, b_s):
    bsz, seq, _ = v.shape
    n_chunks = -(-seq // GM_CHUNK)
    pad = n_chunks * GM_CHUNK - seq
    vp = jnp.pad(v, ((0, 0), (0, pad), (0, 0))).reshape(bsz, n_chunks, GM_CHUNK, GM_HEADS, GM_HEAD_DIM)
    blk = jnp.arange(GM_CHUNK) // CHUNK
    mask = blk[None, :] <= blk[:, None]
    w = jnp.where(mask[None], w_s, jnp.zeros_like(w_s))
    mixed = jnp.einsum('hij,bkjhc->bkihc', w, vp) + jnp.transpose(b_s)[None, None, :, :, None]
    mixed = mixed.reshape(bsz, n_chunks * GM_CHUNK, GM_WIDTH)[:, :seq]
    return u * mixed


def trunk_layer(x, c, x0_re, x0_im, norm1_g, norm2_g, w_ada, b_ada, w_in,
                lam_re, lam_im, log_step, b_re, b_im, c_re, c_im, d, w_glu, b_glu,
                gm_ln_g, gm_ln_b, gm_w_s, gm_b_s, w_out, ffn_w_gu, ffn_w_down):
    mod = (jax.nn.silu(c) @ w_ada + b_ada)[:, None, :]
    shift1, scale1, gate1, shift2, scale2, gate2 = jnp.split(mod, N_MOD, axis=-1)
    h = rmsnorm(x, norm1_g) * (1.0 + scale1) + shift1
    z = h @ w_in
    z_s5, z_u, z_v = jnp.split(z, [S5_WIDTH, S5_WIDTH + GM_WIDTH], axis=-1)
    y_s5, s_re, s_im = s5_mixer(z_s5, x0_re, x0_im, lam_re, lam_im, log_step, b_re, b_im, c_re, c_im, d)
    y_s5 = jax.nn.gelu(y_s5)
    y_s5 = y_s5 * jax.nn.sigmoid(y_s5 @ w_glu + b_glu)
    u = jax.nn.gelu(z_u)
    v = layernorm(jax.nn.gelu(z_v), gm_ln_g, gm_ln_b)
    y_gm = gmlp_mixer(u, v, gm_w_s, gm_b_s)
    x = x + gate1 * (jnp.concatenate([y_s5, y_gm], axis=-1) @ w_out)
    h = rmsnorm(x, norm2_g) * (1.0 + scale2) + shift2
    g, up = jnp.split(h @ ffn_w_gu, 2, axis=-1)
    x = x + gate2 * ((jax.nn.silu(g) * up) @ ffn_w_down)
    return x, s_re, s_im, v


def setup_inputs(seed: int = 0) -> dict:
    key = jax.random.key(seed)
    ks = jax.random.split(key, 32)
    f32 = jnp.float32
    nrm = lambda k, shape, s: jax.random.normal(k, shape, f32) * s
    lam_im0 = math.pi * jnp.arange(S5_STATE, dtype=f32)
    return {
        'x_prompt': nrm(ks[0], (BATCH, SEQ, D_MODEL), 1.0),
        'x_sample': nrm(ks[1], (DEC_BATCH, DEC_SEQ, D_MODEL), 1.0),
        'state_s5_re': nrm(ks[2], (DEPTH, DEC_BATCH, S5_GROUPS, S5_STATE), 0.5),
        'state_s5_im': nrm(ks[3], (DEPTH, DEC_BATCH, S5_GROUPS, S5_STATE), 0.5),
        'c_prompt': nrm(ks[4], (BATCH, D_MODEL), 1.0),
        'c_sample': nrm(ks[5], (DEC_BATCH, D_MODEL), 1.0),
        'norm1_g': 1.0 + nrm(ks[6], (DEPTH, D_MODEL), 0.01),
        'norm2_g': 1.0 + nrm(ks[7], (DEPTH, D_MODEL), 0.01),
        'w_ada': nrm(ks[8], (DEPTH, D_MODEL, N_MOD * D_MODEL), D_MODEL ** -0.5),
        'b_ada': nrm(ks[9], (DEPTH, N_MOD * D_MODEL), 0.01),
        'w_in': nrm(ks[10], (DEPTH, D_MODEL, IN_WIDTH), D_MODEL ** -0.5),
        's5_lambda_re': -0.5 + nrm(ks[11], (DEPTH, S5_GROUPS, S5_STATE), 0.01),
        's5_lambda_im': lam_im0[None, None, :] + nrm(ks[12], (DEPTH, S5_GROUPS, S5_STATE), 0.01),
        's5_log_step': jax.random.uniform(ks[13], (DEPTH, S5_GROUPS), f32, math.log(1e-3), math.log(1e-1)),
        's5_b_re': nrm(ks[14], (DEPTH, S5_GROUPS, S5_STATE, S5_GROUP), (2 * S5_GROUP) ** -0.5),
        's5_b_im': nrm(ks[15], (DEPTH, S5_GROUPS, S5_STATE, S5_GROUP), (2 * S5_GROUP) ** -0.5),
        's5_c_re': nrm(ks[16], (DEPTH, S5_GROUPS, S5_GROUP, S5_STATE), (2 * S5_STATE) ** -0.5),
        's5_c_im': nrm(ks[17], (DEPTH, S5_GROUPS, S5_GROUP, S5_STATE), (2 * S5_STATE) ** -0.5),
        's5_d': nrm(ks[18], (DEPTH, S5_GROUPS, S5_GROUP), 1.0),
        's5_w_glu': nrm(ks[19], (DEPTH, S5_WIDTH, S5_WIDTH), S5_WIDTH ** -0.5),
        's5_b_glu': nrm(ks[20], (DEPTH, S5_WIDTH), 0.01),
        'gm_ln_g': 1.0 + nrm(ks[21], (DEPTH, GM_WIDTH), 0.01),
        'gm_ln_b': nrm(ks[22], (DEPTH, GM_WIDTH), 0.01),
        'gm_w_s': nrm(ks[23], (DEPTH, GM_HEADS, GM_CHUNK, GM_CHUNK), GM_CHUNK ** -0.5),
        'gm_b_s': 1.0 + nrm(ks[24], (DEPTH, GM_HEADS, GM_CHUNK), 0.01),
        'w_out': nrm(ks[25], (DEPTH, MIX_WIDTH, D_MODEL), MIX_WIDTH ** -0.5),
        'ffn_w_gu': nrm(ks[26], (DEPTH, D_MODEL, 2 * D_FF), D_MODEL ** -0.5),
        'ffn_w_down': nrm(ks[27], (DEPTH, D_FF, D_MODEL), D_FF ** -0.5),
        'final_g': 1.0 + nrm(ks[28], (D_MODEL,), 0.01),
    }


def reference(x_prompt, x_sample, state_s5_re, state_s5_im, c_prompt, c_sample,
              norm1_g, norm2_g, w_ada, b_ada, w_in,
              s5_lambda_re, s5_lambda_im, s5_log_step, s5_b_re, s5_b_im, s5_c_re, s5_c_im, s5_d,
              s5_w_glu, s5_b_glu, gm_ln_g, gm_ln_b, gm_w_s, gm_b_s, w_out, ffn_w_gu, ffn_w_down,
              final_g):
    xp = x_prompt
    xs = x_sample
    p_re, p_im, s_re_l, s_im_l, v_l = [], [], [], [], []
    for l in range(DEPTH):
        weights = (norm1_g[l], norm2_g[l], w_ada[l], b_ada[l], w_in[l],
                   s5_lambda_re[l], s5_lambda_im[l], s5_log_step[l], s5_b_re[l], s5_b_im[l],
                   s5_c_re[l], s5_c_im[l], s5_d[l], s5_w_glu[l], s5_b_glu[l],
                   gm_ln_g[l], gm_ln_b[l], gm_w_s[l], gm_b_s[l], w_out[l], ffn_w_gu[l], ffn_w_down[l])
        zero_state = jnp.zeros((xp.shape[0], S5_GROUPS, S5_STATE), xp.dtype)
        xp, pr, pi_, _ = trunk_layer(xp, c_prompt, zero_state, zero_state, *weights)
        xs, sr, si, vs = trunk_layer(xs, c_sample, state_s5_re[l], state_s5_im[l], *weights)
        p_re.append(pr)
        p_im.append(pi_)
        s_re_l.append(sr)
        s_im_l.append(si)
        v_l.append(vs)
    y_prompt = rmsnorm(xp, final_g)
    y_sample = rmsnorm(xs, final_g)
    new_s5_re_prompt = jnp.stack(p_re, axis=0)
    new_s5_im_prompt = jnp.stack(p_im, axis=0)
    new_s5_re_sample = jnp.stack(s_re_l, axis=0)
    new_s5_im_sample = jnp.stack(s_im_l, axis=0)
    new_gm_v_sample = jnp.stack(v_l, axis=0)
    return (y_prompt, y_sample, new_s5_re_prompt, new_s5_im_prompt, new_s5_re_sample, new_s5_im_sample, new_gm_v_sample)
```

```cpp
#include <hip/hip_runtime.h>
#include <hip/hip_cooperative_groups.h>
#include <cstdio>
#include <cstdint>
namespace cg = cooperative_groups;
namespace pg8 {
#define PG8_LAS __attribute__((address_space(3)))
typedef unsigned short bf16_t;
typedef short bf16x8 __attribute__((ext_vector_type(8)));
typedef float f32x4 __attribute__((ext_vector_type(4)));
typedef unsigned u32x4 __attribute__((ext_vector_type(4)));
constexpr int BM = 256, BK = 64, HALF = 128, HTB = HALF * BK * 2  , STAGE_BYTES = 8 * HTB, NXCD = 8, WGM = 8;

__host__ __device__ __forceinline__ int lds_byte(int r, int c) { const int st = (r >> 4) * 2 + (c >> 5), rr = r & 15, cc = c & 31, ob = rr * 64 + cc * 2; return st * 1024 + (ob ^ (((ob >> 9) & 1) << 5)); }
__host__ __device__ __forceinline__ void stage_rc(int b, int& R, int& C) { const int st = b / 1024, sb = b % 1024, swz = sb ^ (((sb >> 9) & 1) << 5); R = (st >> 1) * 16 + swz / 64; C = (st & 1) * 32 + (swz % 64) / 2; }
__host__ __device__ __forceinline__ int perm32(int rho) { const int n = rho >> 4, i = rho & 15; return 8 * (i >> 2) + 4 * n + (i & 3); }

struct Unit { int pm, pn; };
struct Gemm { const bf16_t* A; const bf16_t* Bt; int M, N, K; };

struct StaticOrder {
    int nM, nN, nwg, G, c;
    __host__ __device__ void init(int M, int N, int G_, int c_) { nM = M / BM; nN = N / BM; nwg = nM * nN; G = G_; c = c_; }
    __host__ __device__ bool next(int i, Unit& u) const {
        const long L = (long)i * G + c; if (L >= nwg) return false;
        int wgid = (int)L; { const int q = nwg / NXCD, r = nwg % NXCD, xcd = wgid % NXCD, off = wgid / NXCD; wgid = (xcd < r ? xcd * (q + 1) : r * (q + 1) + (xcd - r) * q) + off; }
        const int nig = WGM * nN, gid = wgid / nig, fm = gid * WGM, gsz = (nM - fm) < WGM ? (nM - fm) : WGM;
        u.pm = fm + ((wgid % nig) % gsz); u.pn = (wgid % nig) / gsz; return true;
    }
    __device__ __forceinline__ void a_ready(const Unit&) const {}
    __device__ __forceinline__ void done(const Unit&) const {}
};
__device__ __forceinline__ unsigned cvt_pk_bf16(float lo, float hi) { unsigned r; asm volatile("v_cvt_pk_bf16_f32 %0, %1, %2" : "=v"(r) : "v"(lo), "v"(hi)); return r; }
template <class Epi, class Sched, bool ALIGN_EPI = false, bool SP2 = false>
__device__ __forceinline__ void gemm_phase(PG8_LAS unsigned char* lds, const Gemm g, const Sched& S, const Epi& E) {
    const int tid = threadIdx.x, wid = __builtin_amdgcn_readfirstlane(tid >> 6), lane = tid & 63, wr = wid >> 2, wc = wid & 3, fr = lane & 15, fq = lane >> 4;
    const int K = g.K, nt = K / BK;
    unsigned voffA[2], voffB[2];
#pragma unroll
    for (int i = 0; i < 2; ++i) { int R, C; stage_rc(tid * 16 + i * 8192, R, C); const int Rb = Epi::PERM ? ((R & ~31) + perm32(R & 31)) : R;
        voffA[i] = (unsigned)(R * K + C) * 2u; voffB[i] = (unsigned)(Rb * K + C) * 2u; }
    const size_t kstep = (size_t)(BK * 2);
    const size_t hstep = (size_t)HALF * K * 2;
    const size_t tstep = 2 * hstep;
    const unsigned ldsw = (unsigned)wid * 1024u;
    const int aoff = lds_byte(wr * 64 + fr, fq * 8), boff = lds_byte(wc * 32 + fr, fq * 8);
#define PG8_SA(b, h) (((b) * 2 + (h)) * HTB)
#define PG8_SB(b, h) ((4 + (b) * 2 + (h)) * HTB)
#define PG8_STAGE(bufoff, gbase, voff) do { _Pragma("unroll") for (int _i = 0; _i < 2; ++_i) \
        __builtin_amdgcn_global_load_lds((const unsigned*)((const char*)(gbase) + (voff)[_i]), (PG8_LAS unsigned*)(lds + (bufoff) + ldsw + _i * 8192), 16, 0, 0); } while (0)
#define PG8_LDA(dst, b, h) do { _Pragma("unroll") for (int m = 0; m < 4; ++m) _Pragma("unroll") for (int k = 0; k < 2; ++k) dst[m][k] = *(const PG8_LAS bf16x8*)(lds + PG8_SA(b, h) + aoff + m * 2048 + k * 1024); } while (0)
#define PG8_LDB(dst, b, h) do { _Pragma("unroll") for (int n = 0; n < 2; ++n) _Pragma("unroll") for (int k = 0; k < 2; ++k) dst[n][k] = *(const PG8_LAS bf16x8*)(lds + PG8_SB(b, h) + boff + n * 2048 + k * 1024); } while (0)
#define PG8_MMA(ai, bj, At, Bt) do { __builtin_amdgcn_s_setprio(1); _Pragma("unroll") for (int m = 0; m < 4; ++m) _Pragma("unroll") for (int n = 0; n < 2; ++n) _Pragma("unroll") for (int k = 0; k < 2; ++k) \
        acc[ai][bj][m][n] = __builtin_amdgcn_mfma_f32_16x16x32_bf16(Bt[n][k], At[m][k], acc[ai][bj][m][n], 0, 0, 0); __builtin_amdgcn_s_setprio(0); } while (0)
#define PG8_WAIT_V(n) asm volatile("s_waitcnt vmcnt(" #n ")" ::: "memory")
#define PG8_WAIT_L(n) asm volatile("s_waitcnt lgkmcnt(" #n ")" ::: "memory")
#define PG8_BAR __builtin_amdgcn_s_barrier()
#define PG8_SCHED __builtin_amdgcn_sched_barrier(0)
    Unit cur, nxt; int ui = 0;
    if (!S.next(0, cur)) return;
    f32x4 acc[2][2][4][2];
#pragma unroll
    for (int a = 0; a < 2; ++a)
#pragma unroll
        for (int b = 0; b < 2; ++b)
#pragma unroll
            for (int m = 0; m < 4; ++m)
#pragma unroll
                for (int n = 0; n < 2; ++n) acc[a][b][m][n] = (f32x4){0.f, 0.f, 0.f, 0.f};
    bf16x8 At[4][2], B0[2][2], B1[2][2];
    const char* cA = (const char*)g.A + (size_t)cur.pm * tstep; const char* cB = (const char*)g.Bt + (size_t)cur.pn * tstep;
    S.a_ready(cur);
    if constexpr (SP2) {
        PG8_STAGE(PG8_SB(0, 0), cB, voffB); PG8_STAGE(PG8_SB(0, 1), cB + hstep, voffB); PG8_STAGE(PG8_SA(0, 0), cA, voffA); PG8_STAGE(PG8_SA(0, 1), cA + hstep, voffA);
        if (wr == 1) PG8_BAR;
        PG8_WAIT_V(2); PG8_BAR;
        PG8_STAGE(PG8_SB(1, 0), cB + kstep, voffB); PG8_STAGE(PG8_SA(1, 0), cA + kstep, voffA); PG8_STAGE(PG8_SB(1, 1), cB + hstep + kstep, voffB);
        PG8_WAIT_V(6); PG8_BAR;
    } else {
        PG8_STAGE(PG8_SB(0, 0), cB, voffB); PG8_STAGE(PG8_SA(0, 0), cA, voffA); PG8_STAGE(PG8_SB(0, 1), cB + hstep, voffB); PG8_STAGE(PG8_SA(0, 1), cA + hstep, voffA);
        if (wr == 1) PG8_BAR;
        PG8_WAIT_V(4); PG8_BAR;
        PG8_STAGE(PG8_SB(1, 0), cB + kstep, voffB); PG8_STAGE(PG8_SA(1, 0), cA + kstep, voffA); PG8_STAGE(PG8_SB(1, 1), cB + hstep + kstep, voffB);
        PG8_WAIT_V(6); PG8_BAR;
    }
    for (;;) {
        const bool has_next = S.next(ui + 1, nxt);
        const char* nA = has_next ? (const char*)g.A + (size_t)nxt.pm * tstep : cA; const char* nB = has_next ? (const char*)g.Bt + (size_t)nxt.pn * tstep : cB;
        for (int t = 0; t < nt; t += 2) {
            const bool last = (t == nt - 2);
            const char* a1 = cA + (size_t)(t + 1) * kstep;
            const char* a2 = last ? nA : cA + (size_t)(t + 2) * kstep; const char* b2 = last ? nB : cB + (size_t)(t + 2) * kstep;
            const char* a3 = a2 + kstep; const char* b3 = b2 + kstep;
            if (last && has_next) S.a_ready(nxt);
            if constexpr (SP2) {
            PG8_LDB(B0, 0, 0); PG8_LDB(B1, 0, 1); PG8_SCHED; PG8_LDA(At, 0, 0); PG8_STAGE(PG8_SA(1, 1), a1 + hstep, voffA);
            PG8_WAIT_V(8); PG8_WAIT_L(0); PG8_BAR; PG8_MMA(0, 0, At, B0); PG8_MMA(0, 1, At, B1); PG8_BAR; PG8_SCHED;
            PG8_LDA(At, 0, 1); PG8_STAGE(PG8_SB(0, 0), b2, voffB); PG8_STAGE(PG8_SB(0, 1), b2 + hstep, voffB); PG8_STAGE(PG8_SA(0, 0), a2, voffA);
            PG8_WAIT_V(8); PG8_WAIT_L(0); PG8_BAR; PG8_MMA(1, 0, At, B0); PG8_MMA(1, 1, At, B1); PG8_BAR; PG8_SCHED;
            PG8_LDB(B0, 1, 0); PG8_LDB(B1, 1, 1); PG8_SCHED; PG8_LDA(At, 1, 0); PG8_STAGE(PG8_SA(0, 1), a2 + hstep, voffA);
            PG8_WAIT_V(8); PG8_WAIT_L(0); PG8_BAR; PG8_MMA(0, 0, At, B0); PG8_MMA(0, 1, At, B1); PG8_BAR; PG8_SCHED;
            PG8_LDA(At, 1, 1); PG8_STAGE(PG8_SB(1, 0), b3, voffB); PG8_STAGE(PG8_SB(1, 1), b3 + hstep, voffB); PG8_STAGE(PG8_SA(1, 0), a3, voffA);
            PG8_WAIT_V(8); PG8_WAIT_L(0); PG8_BAR; PG8_MMA(1, 0, At, B0); PG8_MMA(1, 1, At, B1); PG8_BAR; PG8_SCHED;
            } else {
            PG8_LDB(B0, 0, 0); PG8_SCHED; PG8_LDA(At, 0, 0); PG8_STAGE(PG8_SA(1, 1), a1 + hstep, voffA);
            PG8_WAIT_L(8); PG8_BAR; PG8_WAIT_L(0); PG8_MMA(0, 0, At, B0); PG8_BAR; PG8_SCHED;
            PG8_LDB(B1, 0, 1); PG8_STAGE(PG8_SB(0, 0), b2, voffB);
            PG8_BAR; PG8_WAIT_L(0); PG8_MMA(0, 1, At, B1); PG8_BAR;
            PG8_LDA(At, 0, 1); PG8_STAGE(PG8_SA(0, 0), a2, voffA);
            PG8_BAR; PG8_WAIT_L(0); PG8_MMA(1, 0, At, B0); PG8_BAR; PG8_SCHED;
            PG8_STAGE(PG8_SB(0, 1), b2 + hstep, voffB);
            PG8_WAIT_V(6); PG8_BAR; PG8_MMA(1, 1, At, B1); PG8_BAR;
            PG8_LDB(B0, 1, 0); PG8_SCHED; PG8_LDA(At, 1, 0); PG8_STAGE(PG8_SA(0, 1), a2 + hstep, voffA);
            PG8_WAIT_L(8); PG8_BAR; PG8_WAIT_L(0); PG8_MMA(0, 0, At, B0); PG8_BAR; PG8_SCHED;
            PG8_LDB(B1, 1, 1); PG8_STAGE(PG8_SB(1, 0), b3, voffB);
            PG8_BAR; PG8_WAIT_L(0); PG8_MMA(0, 1, At, B1); PG8_BAR;
            PG8_LDA(At, 1, 1); PG8_STAGE(PG8_SA(1, 0), a3, voffA);
            PG8_BAR; PG8_WAIT_L(0); PG8_MMA(1, 0, At, B0); PG8_BAR; PG8_SCHED;
            PG8_STAGE(PG8_SB(1, 1), b3 + hstep, voffB);
            PG8_WAIT_V(6); PG8_BAR; PG8_MMA(1, 1, At, B1); PG8_BAR;
            }
        }
        if constexpr (ALIGN_EPI) { if (wr == 0) PG8_BAR; }
        if constexpr (!Epi::AFTER_DRAIN) { E(acc, cur, wr, wc, fr, fq); S.done(cur); }
        if (!has_next) break;
#pragma unroll
        for (int a = 0; a < 2; ++a)
#pragma unroll
            for (int b = 0; b < 2; ++b)
#pragma unroll
                for (int m = 0; m < 4; ++m)
#pragma unroll
                    for (int n = 0; n < 2; ++n) acc[a][b][m][n] = (f32x4){0.f, 0.f, 0.f, 0.f};
        cur = nxt; cA = nA; cB = nB; ++ui;
        if constexpr (ALIGN_EPI) { if (wr == 1) PG8_BAR; }
    }
    PG8_WAIT_V(0);
    if constexpr (!ALIGN_EPI) { if (wr == 0) PG8_BAR; }
    PG8_BAR;
    if constexpr (Epi::AFTER_DRAIN) { E.fused(acc, cur, wr, wc, fr, fq, lds, wid, lane); S.done(cur); }
#undef PG8_SA
#undef PG8_SB
#undef PG8_STAGE
#undef PG8_LDA
#undef PG8_LDB
#undef PG8_MMA
#undef PG8_WAIT_V
#undef PG8_WAIT_L
#undef PG8_BAR
#undef PG8_SCHED
}
}

#define GAS __attribute__((address_space(1)))
#define LAS __attribute__((address_space(3)))
typedef unsigned short bf16;
typedef unsigned v4u __attribute__((ext_vector_type(4)));
typedef unsigned v2u __attribute__((ext_vector_type(2)));
typedef float f32x4 __attribute__((ext_vector_type(4)));
typedef float f32x2 __attribute__((ext_vector_type(2)));
typedef float f32x16 __attribute__((ext_vector_type(16)));
typedef short bf16x8 __attribute__((ext_vector_type(8)));
using pg8::cvt_pk_bf16;

constexpr int D = 1024, SEQ = 16384, NSB = 8, NST = 32, M = SEQ + NSB * NST  , INW = 1536, DFF = 2816, GUW = 2 * DFF, NMOD = 6 * D;
constexpr int NCH = M / 32;
constexpr float EPS = 1e-6f;
constexpr size_t O_PRE = (size_t)M * D, O_PIM = O_PRE + 2048, O_SRE = O_PIM + 2048, O_SIM = O_SRE + 16384, O_V = O_SIM + 16384;

constexpr size_t MiB = 1u << 20, KiB = 1u << 10;
constexpr size_t WS_MODP = 1 * MiB;
constexpr size_t WS_MODF = 2 * MiB;
constexpr size_t WS_TB = 2 * MiB + 512 * KiB;
constexpr size_t WS_TC = WS_TB + 128 * KiB;
constexpr size_t WS_TA = WS_TC + 128 * KiB;
constexpr size_t WS_TP = WS_TA + 64 * KiB;
constexpr size_t WS_WIN = 4 * MiB, WS_WGLU = 7 * MiB, WS_WOUT = 8 * MiB, WS_WGU = 10 * MiB, WS_WD = 21 * MiB;
constexpr size_t WS_SLOC = 27 * MiB, WS_SST = 35 * MiB;
constexpr size_t WS_H = 44 * MiB;
constexpr size_t WS_X1 = 77 * MiB;
constexpr size_t ACT5 = (size_t)M * 512 * 2;
constexpr size_t WS_ZS5 = 142 * MiB, WS_UG = WS_ZS5 + ACT5, WS_GV = WS_UG + ACT5, WS_YS = WS_GV + ACT5, WS_CAT = WS_YS + ACT5;
constexpr size_t WS_HID = 142 * MiB;
constexpr size_t WS_END = WS_CAT + (size_t)M * 1024 * 2;
static_assert(WS_END <= 256 * MiB && WS_HID + (size_t)M * DFF * 2 <= WS_END, "ws map");
constexpr int LDS_BYTES = 147456;
constexpr int NPH = 12;

__device__ __forceinline__ float bf2f(unsigned short b) { return __builtin_bit_cast(float, ((unsigned)b) << 16); }
__device__ __forceinline__ float bflo(unsigned w) { return __builtin_bit_cast(float, w << 16); }
__device__ __forceinline__ float bfhi(unsigned w) { return __builtin_bit_cast(float, w & 0xffff0000u); }
__device__ __forceinline__ float sigm(float x) { return __builtin_amdgcn_rcpf(1.f + __expf(-x)); }
__device__ __forceinline__ float gelu_t(float x) { const float z = 1.5957691216f * (x + 0.044715f * x * x * x); return x * sigm(z); }
__device__ __forceinline__ float silu_f(float x) { return x * sigm(x); }
__device__ __forceinline__ float wave_sum(float v) {
#pragma unroll
    for (int o = 1; o < 64; o <<= 1) v += __shfl_xor(v, o);
    return v;
}
#define LDS_WAIT() asm volatile("s_waitcnt lgkmcnt(0)" ::: "memory")

struct Args { const float* in[29]; float* out; unsigned char* ws; int ph_lo, ph_hi; };

__device__ __forceinline__ void p0_transpose_item(const float* W, int K, int N, bf16* WT, int dst_row0, LAS float* scr, int kb, int nb, int lane) {
    const int k0 = 64 * kb, n0 = 32 * nb;
#pragma unroll 8
    for (int i = 0; i < 32; ++i) { const int kk = 2 * i + (lane >> 5); scr[kk * 33 + (lane & 31)] = W[(size_t)(k0 + kk) * N + n0 + (lane & 31)]; }
    LDS_WAIT();
    const int c = lane & 7;
#pragma unroll
    for (int j = 0; j < 4; ++j) { const int n = (lane >> 3) + 8 * j; const LAS float* s = scr + (8 * c) * 33 + n;
        v4u o; o.x = cvt_pk_bf16(s[0 * 33], s[1 * 33]); o.y = cvt_pk_bf16(s[2 * 33], s[3 * 33]); o.z = cvt_pk_bf16(s[4 * 33], s[5 * 33]); o.w = cvt_pk_bf16(s[6 * 33], s[7 * 33]);
        *(v4u*)(WT + (size_t)(dst_row0 + n) * K + k0 + 8 * c) = o; }
    LDS_WAIT();
}
__device__ __forceinline__ float rl(float v, int l) { return __builtin_bit_cast(float, __builtin_amdgcn_readlane(__builtin_bit_cast(int, v), l)); }

__device__ __forceinline__ void p0_ada_item(const Args& a, int cs, int ks, int lane) {
    const float* cp = a.in[4]; const float* csm = a.in[5]; const float* W = a.in[8];
    float* modp = (float*)(a.ws + WS_MODP);
    const int c0 = cs * 256 + 4 * lane, k0 = ks * 256;
    float sl[9][4];
#pragma unroll
    for (int b = 0; b < 9; ++b)
#pragma unroll
        for (int jj = 0; jj < 4; ++jj) { const int k = k0 + jj * 64 + lane; const float cv = (b == 0) ? cp[k] : csm[(b - 1) * D + k]; sl[b][jj] = silu_f(cv); }
    f32x4 acc[9];
#pragma unroll
    for (int b = 0; b < 9; ++b) acc[b] = (f32x4){0.f, 0.f, 0.f, 0.f};
#pragma unroll
    for (int jj = 0; jj < 4; ++jj) {
#pragma unroll 8
        for (int kk = 0; kk < 64; ++kk) {
            const f32x4 w = *(const f32x4*)(W + (size_t)(k0 + jj * 64 + kk) * NMOD + c0);
#pragma unroll
            for (int b = 0; b < 9; ++b) { const float s = rl(sl[b][jj], kk); acc[b] += w * s; }
        }
    }
#pragma unroll
    for (int b = 0; b < 9; ++b) *(f32x4*)(modp + ((size_t)ks * 9 + b) * NMOD + c0) = acc[b];
}

__device__ __forceinline__ void p0_s5_tables(const Args& a, int g, int lane) {
    const int n = lane;
    const float step = expf(a.in[13][g]);
    const float lr = a.in[11][g * 64 + n], li = a.in[12][g * 64 + n];
    const float x = lr * step, y = li * step;
    const float ex = expf(x), cy = cosf(y), sy = sinf(y), sh = sinf(0.5f * y);
    const float a1r = ex * cy, a1i = ex * sy;
    const float mr = expm1f(x) * cy - 2.f * sh * sh, mi = ex * sy;
    const float den = lr * lr + li * li;
    const float fr = (mr * lr + mi * li) / den, fi = (mi * lr - mr * li) / den;
    bf16* TB = (bf16*)(a.ws + WS_TB); bf16* TC = (bf16*)(a.ws + WS_TC); float* TA = (float*)(a.ws + WS_TA); float* TP = (float*)(a.ws + WS_TP);
    const float* br = a.in[14] + (size_t)(g * 64 + n) * 16; const float* bi = a.in[15] + (size_t)(g * 64 + n) * 16;
    const int xx = n >> 1, sbit = n & 1;
    bf16* rowre = TB + (size_t)(g * 128 + (0 + sbit) * 32 + xx) * 16;
    bf16* rowim = TB + (size_t)(g * 128 + (2 + sbit) * 32 + xx) * 16;
#pragma unroll
    for (int q = 0; q < 16; q += 2) {
        const float b0r = br[q], b0i = bi[q], b1r = br[q + 1], b1i = bi[q + 1];
        *(unsigned*)(rowre + q) = cvt_pk_bf16(fr * b0r - fi * b0i, fr * b1r - fi * b1i);
        *(unsigned*)(rowim + q) = cvt_pk_bf16(fr * b0i + fi * b0r, fr * b1i + fi * b1r);
    }
    double pr = a1r, pi = a1i;
    double p2r = pr * pr - pi * pi, p2i = 2.0 * pr * pi;
    double p3r = p2r * pr - p2i * pi, p3i = p2r * pi + p2i * pr;
    double p4r = p2r * p2r - p2i * p2i, p4i = 2.0 * p2r * p2i;
    float* ta = TA + (size_t)(g * 64 + n) * 8;
    ta[0] = (float)pr; ta[1] = (float)pi; ta[2] = (float)p2r; ta[3] = (float)p2i; ta[4] = (float)p3r; ta[5] = (float)p3i; ta[6] = (float)p4r; ta[7] = (float)p4i;
    double qr = p4r, qi = p4i;
#pragma unroll
    for (int s = 0; s < 3; ++s) { const double t = qr * qr - qi * qi; qi = 2.0 * qr * qi; qr = t; }
    float* tp = TP + (size_t)(g * 64 + n) * 4;
    tp[0] = (float)qr; tp[1] = (float)qi;
#pragma unroll
    for (int s = 0; s < 6; ++s) { const double t = qr * qr - qi * qi; qi = 2.0 * qr * qi; qr = t; }
    tp[2] = (float)qr; tp[3] = (float)qi;
    const float* cr = a.in[16] + (size_t)g * 16 * 64; const float* ci = a.in[17] + (size_t)g * 16 * 64;
#pragma unroll
    for (int p = 0; p < 16; ++p) { TC[(size_t)(g * 16 + p) * 128 + n] = (bf16)(cvt_pk_bf16(cr[p * 64 + n], 0.f) & 0xffffu); TC[(size_t)(g * 16 + p) * 128 + 64 + n] = (bf16)(cvt_pk_bf16(-ci[p * 64 + n], 0.f) & 0xffffu); }
}

__device__ __forceinline__ void p0_prologue(const Args& a, LAS unsigned char* lds, int vw, int NGW, int wave, int lane) {
    LAS float* scr = (LAS float*)(lds + wave * 16384);
    constexpr int I_ADA = 96, I_S5 = 32, I_IN = 16 * 48, I_GLU = 8 * 16, I_OUT = 16 * 32, I_GU = 16 * 176, I_D = 44 * 32;
    constexpr int NITEMS = I_ADA + I_S5 + I_IN + I_GLU + I_OUT + I_GU + I_D;
    for (int it = vw; it < NITEMS; it += NGW) {
        int r = it;
        if (r < I_ADA) { p0_ada_item(a, r % 24, r / 24, lane); continue; } r -= I_ADA;
        if (r < I_S5) { p0_s5_tables(a, r, lane); continue; } r -= I_S5;
        if (r < I_IN) { const int nblk = INW / 32, kb = r / nblk, nb = r % nblk; p0_transpose_item(a.in[10], D, INW, (bf16*)(a.ws + WS_WIN), 32 * nb, scr, kb, nb, lane); continue; } r -= I_IN;
        if (r < I_GLU) { const int nblk = 16, kb = r / nblk, nb = r % nblk; p0_transpose_item(a.in[19], 512, 512, (bf16*)(a.ws + WS_WGLU), 32 * nb, scr, kb, nb, lane); continue; } r -= I_GLU;
        if (r < I_OUT) { const int nblk = 32, kb = r / nblk, nb = r % nblk; p0_transpose_item(a.in[25], D, D, (bf16*)(a.ws + WS_WOUT), 32 * nb, scr, kb, nb, lane); continue; } r -= I_OUT;
        if (r < I_GU) { const int nblk = GUW / 32, kb = r / nblk, nb = r % nblk; const int n0 = 32 * nb; const int j = n0 < DFF ? n0 : n0 - DFF;
            const int drow = 256 * (j >> 7) + (n0 < DFF ? 0 : 128) + (j & 127);
            p0_transpose_item(a.in[26], D, GUW, (bf16*)(a.ws + WS_WGU), drow, scr, kb, nb, lane); continue; } r -= I_GU;
        { const int nblk = 32, kb = r / nblk, nb = r % nblk; p0_transpose_item(a.in[27], DFF, D, (bf16*)(a.ws + WS_WD), 32 * nb, scr, kb, nb, lane); }
    }
}

template <int WHICH>
__device__ __forceinline__ void hprep(const Args& a, int vw, int NGW, int lane) {
    const float* gvec = a.in[WHICH == 0 ? 6 : 7];
    const float* modp = (const float*)(a.ws + WS_MODP); const float* modf = (const float*)(a.ws + WS_MODF); const float* bada = a.in[9];
    bf16* H = (bf16*)(a.ws + WS_H);
    const int soff = WHICH == 0 ? 0 : 3 * D, coff = soff + D;
    int cur = -1; f32x4 ca[4], cb[4];
    for (int m = vw; m < M; m += NGW) {
        const int mr = m < SEQ ? 0 : 1 + ((m - SEQ) >> 5);
        if (mr != cur) { cur = mr;
#pragma unroll
            for (int j = 0; j < 4; ++j) { const int k = 4 * lane + 256 * j; f32x4 sc, sh;
                if (WHICH == 0) { sc = *(const f32x4*)(bada + coff + k); sh = *(const f32x4*)(bada + soff + k);
#pragma unroll
                    for (int ks = 0; ks < 4; ++ks) { sc += *(const f32x4*)(modp + ((size_t)ks * 9 + mr) * NMOD + coff + k); sh += *(const f32x4*)(modp + ((size_t)ks * 9 + mr) * NMOD + soff + k); } }
                else { sc = *(const f32x4*)(modf + (size_t)mr * NMOD + coff + k); sh = *(const f32x4*)(modf + (size_t)mr * NMOD + soff + k); }
                const f32x4 gg = *(const f32x4*)(gvec + k); ca[j] = gg * (sc + 1.0f); cb[j] = sh; } }
        const float* xrow = WHICH == 0 ? (m < SEQ ? a.in[0] + (size_t)m * D : a.in[1] + (size_t)(m - SEQ) * D) : (const float*)(a.ws + WS_X1) + (size_t)m * D;
        f32x4 v[4]; float ss = 0.f;
#pragma unroll
        for (int j = 0; j < 4; ++j) { v[j] = *(const f32x4*)(xrow + 4 * lane + 256 * j); ss += (v[j].x * v[j].x + v[j].y * v[j].y) + (v[j].z * v[j].z + v[j].w * v[j].w); }
        const float rstd = 1.0f / sqrtf(wave_sum(ss) * (1.0f / D) + EPS);
#pragma unroll
        for (int j = 0; j < 4; ++j) { const f32x4 o = v[j] * rstd * ca[j] + cb[j]; v2u w; w.x = cvt_pk_bf16(o.x, o.y); w.y = cvt_pk_bf16(o.z, o.w);
            *(v2u*)(H + (size_t)m * D + 4 * lane + 256 * j) = w; }
    }
}

using pg8::Unit;
struct EpiIn {
    static constexpr bool PERM = true, AFTER_DRAIN = false;
    bf16 *zs5, *ug, *gv;
    __device__ __forceinline__ void operator()(const f32x4 (&acc)[2][2][4][2], const Unit& u, int wr, int wc, int fr, int fq) const {
        const int sec = u.pn >> 1; bf16* base = zs5 + (size_t)sec * (ACT5 / 2);
        const int row0 = u.pm * 256 + wr * 64 + fr, col0 = (u.pn & 1) * 256 + wc * 32 + 8 * fq;
#pragma unroll
        for (int ai = 0; ai < 2; ++ai)
#pragma unroll
            for (int m = 0; m < 4; ++m) { bf16* rowp = base + (size_t)(row0 + ai * 128 + m * 16) * 512 + col0;
#pragma unroll
                for (int bj = 0; bj < 2; ++bj) { const f32x4 v0 = acc[ai][bj][m][0], v1 = acc[ai][bj][m][1];
                    v4u w;
                    if (sec) { w.x = cvt_pk_bf16(gelu_t(v0.x), gelu_t(v0.y)); w.y = cvt_pk_bf16(gelu_t(v0.z), gelu_t(v0.w)); w.z = cvt_pk_bf16(gelu_t(v1.x), gelu_t(v1.y)); w.w = cvt_pk_bf16(gelu_t(v1.z), gelu_t(v1.w)); }
                    else { w.x = cvt_pk_bf16(v0.x, v0.y); w.y = cvt_pk_bf16(v0.z, v0.w); w.z = cvt_pk_bf16(v1.x, v1.y); w.w = cvt_pk_bf16(v1.z, v1.w); }
                    *(v4u*)(rowp + bj * 128) = w; }
                asm volatile("" ::: "memory"); }
    }
};
struct EpiGlu {
    static constexpr bool PERM = true, AFTER_DRAIN = false;
    const bf16* ys; bf16* cat; const float* bias;
    __device__ __forceinline__ void operator()(const f32x4 (&acc)[2][2][4][2], const Unit& u, int wr, int wc, int fr, int fq) const {
        const int row0 = u.pm * 256 + wr * 64 + fr, col0 = u.pn * 256 + wc * 32 + 8 * fq;
        f32x4 bv[2][2];
#pragma unroll
        for (int bj = 0; bj < 2; ++bj)
#pragma unroll
            for (int n = 0; n < 2; ++n) bv[bj][n] = *(const f32x4*)(bias + col0 + bj * 128 + 4 * n);
#pragma unroll
        for (int ai = 0; ai < 2; ++ai)
#pragma unroll
            for (int m = 0; m < 4; ++m) { const size_t r = (size_t)(row0 + ai * 128 + m * 16);
#pragma unroll
                for (int bj = 0; bj < 2; ++bj) { const f32x4 g0 = acc[ai][bj][m][0] + bv[bj][0], g1 = acc[ai][bj][m][1] + bv[bj][1];
                    const v4u y = *(const v4u*)(ys + r * 512 + col0 + bj * 128);
                    v4u w;
                    w.x = cvt_pk_bf16(bflo(y.x) * sigm(g0[0]), bfhi(y.x) * sigm(g0[1])); w.y = cvt_pk_bf16(bflo(y.y) * sigm(g0[2]), bfhi(y.y) * sigm(g0[3]));
                    w.z = cvt_pk_bf16(bflo(y.z) * sigm(g1[0]), bfhi(y.z) * sigm(g1[1])); w.w = cvt_pk_bf16(bflo(y.w) * sigm(g1[2]), bfhi(y.w) * sigm(g1[3]));
                    *(v4u*)(cat + r * 1024 + col0 + bj * 128) = w; } }
    }
};
struct EpiRes {
    static constexpr bool PERM = false, AFTER_DRAIN = false;
    const float* bp; const float* bs; const float* gate  ; float* out;
    __device__ __forceinline__ void operator()(const f32x4 (&acc)[2][2][4][2], const Unit& u, int wr, int wc, int fr, int fq) const {
        const int col0 = u.pn * 256 + wc * 32 + 4 * fq;
#pragma unroll
        for (int ai = 0; ai < 2; ++ai)
#pragma unroll
            for (int m = 0; m < 4; ++m) { const int rl_ = ai * 128 + wr * 64 + m * 16 + fr; const int row = u.pm * 256 + rl_;
                const float* brow = row < SEQ ? bp + (size_t)row * D : bs + (size_t)(row - SEQ) * D;
                const int mr = row < SEQ ? 0 : 1 + ((row - SEQ) >> 5);
                const float* grow = gate + (size_t)mr * NMOD;
#pragma unroll
                for (int bj = 0; bj < 2; ++bj)
#pragma unroll
                    for (int n = 0; n < 2; ++n) { const int c = col0 + bj * 128 + n * 16;
                        const f32x4 b = *(const f32x4*)(brow + c), g = *(const f32x4*)(grow + c);
                        *(f32x4*)(out + (size_t)row * D + c) = b + g * acc[ai][bj][m][n]; }
                asm volatile("" ::: "memory"); }
    }
};
struct EpiGU {
    static constexpr bool PERM = true, AFTER_DRAIN = false;
    bf16* hid;
    __device__ __forceinline__ void operator()(const f32x4 (&acc)[2][2][4][2], const Unit& u, int wr, int wc, int fr, int fq) const {
        const int row0 = u.pm * 256 + wr * 64 + fr, col0 = u.pn * 128 + wc * 32 + 8 * fq;
#pragma unroll
        for (int ai = 0; ai < 2; ++ai)
#pragma unroll
            for (int m = 0; m < 4; ++m) { bf16* rowp = hid + (size_t)(row0 + ai * 128 + m * 16) * DFF + col0;
                const f32x4 g0 = acc[ai][0][m][0], g1 = acc[ai][0][m][1], u0 = acc[ai][1][m][0], u1 = acc[ai][1][m][1];
                v4u w; w.x = cvt_pk_bf16(silu_f(g0[0]) * u0[0], silu_f(g0[1]) * u0[1]); w.y = cvt_pk_bf16(silu_f(g0[2]) * u0[2], silu_f(g0[3]) * u0[3]);
                w.z = cvt_pk_bf16(silu_f(g1[0]) * u1[0], silu_f(g1[1]) * u1[1]); w.w = cvt_pk_bf16(silu_f(g1[2]) * u1[2], silu_f(g1[3]) * u1[3]);
                *(v4u*)rowp = w; }
    }
};

#define MFMA32(a, b, c) __builtin_amdgcn_mfma_f32_32x32x16_bf16((a), (b), (c), 0, 0, 0)
#define MFMA16(a, b, c) __builtin_amdgcn_mfma_f32_16x16x32_bf16((a), (b), (c), 0, 0, 0)
template <bool FULL>
__device__ __forceinline__ void s5_item(const Args& a, int g, int ch, LAS unsigned char* sbuf, int lane) {
    const int half = lane >> 5, x = lane & 31, m0 = ch * 32;
    const bf16* ZS5 = (const bf16*)(a.ws + WS_ZS5);
    const bf16* TB = (const bf16*)(a.ws + WS_TB); const float* TA = (const float*)(a.ws + WS_TA);
    const bf16x8 ua = *(const bf16x8*)(ZS5 + (size_t)(m0 + x) * 512 + g * 16 + half * 8);
    f32x16 acc[4];
#pragma unroll
    for (int c = 0; c < 4; ++c) { const bf16x8 bb = *(const bf16x8*)(TB + (size_t)(g * 128 + c * 32 + x) * 16 + half * 8);
        f32x16 z;
#pragma unroll
        for (int r = 0; r < 16; ++r) z[r] = 0.f;
        acc[c] = MFMA32(ua, bb, z); }
    float endr[2], endi[2];
#pragma unroll
    for (int s = 0; s < 2; ++s) {
        const f32x4 t0 = *(const f32x4*)(TA + (size_t)(g * 64 + 2 * x + s) * 8), t1 = *(const f32x4*)(TA + (size_t)(g * 64 + 2 * x + s) * 8 + 4);
        const float apr[4] = {t0.x, t0.z, t1.x, t1.z}, api[4] = {t0.y, t0.w, t1.y, t1.w};
        const float a1r = apr[0], a1i = api[0], a4r = apr[3], a4i = api[3];
        f32x16& R = acc[s]; f32x16& I = acc[2 + s];
#pragma unroll
        for (int i = 0; i < 4; ++i)
#pragma unroll
            for (int j = 1; j < 4; ++j) { const int r = 4 * i + j; const float pr = R[r - 1], pi = I[r - 1];
                R[r] += a1r * pr - a1i * pi; I[r] += a1r * pi + a1i * pr; }
        float cr = 0.f, ci = 0.f;
        if (FULL) {
            const int n = 2 * x + s;
            if (ch >= 512) { const int b = ch - 512; cr = a.in[2][(size_t)(b * 32 + g) * 64 + n]; ci = a.in[3][(size_t)(b * 32 + g) * 64 + n]; }
            else if (ch > 0) { const float* sst = (const float*)(a.ws + WS_SST) + (size_t)(ch * 32 + g) * 128; cr = sst[n]; ci = sst[64 + n]; }
        }
        float cinr[4], cini[4];
#pragma unroll
        for (int i = 0; i < 4; ++i) {
            const float lr_ = R[4 * i + 3], li_ = I[4 * i + 3];
            const float candr = a4r * cr - a4i * ci + lr_, candi = a4r * ci + a4i * cr + li_;
            const float othr = __shfl_xor(candr, 32), othi = __shfl_xor(candi, 32);
            cinr[i] = half ? othr : cr; cini[i] = half ? othi : ci;
            const float outr = a4r * cinr[i] - a4i * cini[i] + lr_, outi = a4r * cini[i] + a4i * cinr[i] + li_;
            cr = __shfl_xor(outr, 32); ci = __shfl_xor(outi, 32);
        }
        endr[s] = cr; endi[s] = ci;
        if (FULL) {
#pragma unroll
            for (int i = 0; i < 4; ++i)
#pragma unroll
                for (int j = 0; j < 4; ++j) { const int r = 4 * i + j;
                    R[r] += apr[j] * cinr[i] - api[j] * cini[i]; I[r] += apr[j] * cini[i] + api[j] * cinr[i]; }
        }
    }
    if (!FULL) {
        if (half == 0) { float* sl = (float*)(a.ws + WS_SLOC) + (size_t)(ch * 32 + g) * 128;
            *(f32x2*)(sl + 2 * x) = (f32x2){endr[0], endr[1]}; *(f32x2*)(sl + 64 + 2 * x) = (f32x2){endi[0], endi[1]}; }
        return;
    }
    if (half == 0 && ch >= 511) {
        float* ore = ch == 511 ? a.out + O_PRE + g * 64 : a.out + O_SRE + (size_t)((ch - 512) * 32 + g) * 64;
        float* oim = ch == 511 ? a.out + O_PIM + g * 64 : a.out + O_SIM + (size_t)((ch - 512) * 32 + g) * 64;
        *(f32x2*)(ore + 2 * x) = (f32x2){endr[0], endr[1]}; *(f32x2*)(oim + 2 * x) = (f32x2){endi[0], endi[1]};
    }
#pragma unroll
    for (int r = 0; r < 16; ++r) { const int t = (r & 3) + 8 * (r >> 2) + 4 * half;
        *(LAS unsigned*)(sbuf + t * 272 + 4 * x) = cvt_pk_bf16(acc[0][r], acc[1][r]);
        *(LAS unsigned*)(sbuf + t * 272 + 128 + 4 * x) = cvt_pk_bf16(acc[2][r], acc[3][r]); }
    LDS_WAIT();
    const bf16* TC = (const bf16*)(a.ws + WS_TC);
    f32x4 y[2] = {(f32x4){0.f, 0.f, 0.f, 0.f}, (f32x4){0.f, 0.f, 0.f, 0.f}};
    const int l15 = lane & 15, q4 = lane >> 4;
#pragma unroll
    for (int ks = 0; ks < 4; ++ks) { const bf16x8 ca = *(const bf16x8*)(TC + (size_t)(g * 16 + l15) * 128 + ks * 32 + q4 * 8);
#pragma unroll
        for (int tt = 0; tt < 2; ++tt) { const bf16x8 sb = *(const LAS bf16x8*)(sbuf + (tt * 16 + l15) * 272 + (ks * 32 + q4 * 8) * 2); y[tt] = MFMA16(ca, sb, y[tt]); } }
    LDS_WAIT();
    bf16* YS = (bf16*)(a.ws + WS_YS);
    const f32x4 dd = *(const f32x4*)(a.in[18] + g * 16 + q4 * 4);
#pragma unroll
    for (int tt = 0; tt < 2; ++tt) { const size_t off = (size_t)(m0 + tt * 16 + l15) * 512 + g * 16 + q4 * 4;
        const v2u uu = *(const v2u*)(ZS5 + off);
        const float o0 = gelu_t(y[tt][0] + dd[0] * bflo(uu.x)), o1 = gelu_t(y[tt][1] + dd[1] * bfhi(uu.x)), o2 = gelu_t(y[tt][2] + dd[2] * bflo(uu.y)), o3 = gelu_t(y[tt][3] + dd[3] * bfhi(uu.y));
        v2u w; w.x = cvt_pk_bf16(o0, o1); w.y = cvt_pk_bf16(o2, o3); *(v2u*)(YS + off) = w; }
}

__device__ __forceinline__ void s5_chunk_scan(const Args& a, int g, LAS unsigned char* lds, int tid) {
    const int n = tid & 63, seg = tid >> 6;
    const float* TP = (const float*)(a.ws + WS_TP) + (size_t)(g * 64 + n) * 4;
    const float pr = TP[0], pi = TP[1], qr = TP[2], qi = TP[3];
    const float* sl = (const float*)(a.ws + WS_SLOC) + (size_t)(seg * 64) * 4096 + g * 128 + n;
    float* st = (float*)(a.ws + WS_SST) + (size_t)(seg * 64) * 4096 + g * 128 + n;
    float vr = 0.f, vi = 0.f;
#pragma unroll 8
    for (int k = 0; k < 64; ++k) { const float lr_ = sl[(size_t)k * 4096], li_ = sl[(size_t)k * 4096 + 64]; const float t = pr * vr - pi * vi + lr_; vi = pr * vi + pi * vr + li_; vr = t; }
    LAS f32x2* agg = (LAS f32x2*)lds;
    agg[seg * 64 + n] = (f32x2){vr, vi};
    __syncthreads();
    float cr = 0.f, ci = 0.f;
    for (int s = 0; s < seg; ++s) { const f32x2 ag = agg[s * 64 + n]; const float t = qr * cr - qi * ci + ag.x; ci = qr * ci + qi * cr + ag.y; cr = t; }
    vr = cr; vi = ci;
#pragma unroll 8
    for (int k = 0; k < 64; ++k) { st[(size_t)k * 4096] = vr; st[(size_t)k * 4096 + 64] = vi;
        const float lr_ = sl[(size_t)k * 4096], li_ = sl[(size_t)k * 4096 + 64]; const float t = pr * vr - pi * vi + lr_; vi = pr * vi + pi * vr + li_; vr = t; }
    __syncthreads();
}

__device__ __forceinline__ void gmlp_item(const Args& a, int it, LAS unsigned char* lds, int tid) {
    const int lane = tid & 63, wave = tid >> 6;
    const int m0 = it < 128 ? it * 128 : SEQ + (it - 128) * 32, ntok = it < 128 ? 128 : 32;
    const bf16* GV = (const bf16*)(a.ws + WS_GV); const bf16* UG = (const bf16*)(a.ws + WS_UG); bf16* CAT = (bf16*)(a.ws + WS_CAT);
    constexpr int VP = 272;
    { const int tk = tid >> 2, part = tid & 3;
        if (tk < ntok) {
            const bf16* src = GV + (size_t)(m0 + tk) * 512 + part * 128;
            float s = 0.f, q = 0.f;
#pragma unroll 4
            for (int i = 0; i < 16; ++i) { const v4u rw = *(const v4u*)(src + 8 * i); const unsigned wv[4] = {rw.x, rw.y, rw.z, rw.w};
#pragma unroll
                for (int e = 0; e < 4; ++e) { const float d0 = bflo(wv[e]), d1 = bfhi(wv[e]); s += d0 + d1; q += d0 * d0 + d1 * d1; } }
            s += __shfl_xor(s, 1); s += __shfl_xor(s, 2); q += __shfl_xor(q, 1); q += __shfl_xor(q, 2);
            const float mean = s * (1.0f / 512.0f);
            const float rstd = 1.0f / sqrtf(fmaxf(q * (1.0f / 512.0f) - mean * mean, 0.f) + EPS);
            const float* lg = a.in[21] + part * 128; const float* lb = a.in[22] + part * 128;
            float* vout = (it >= 128) ? a.out + O_V + (size_t)((it - 128) * 32 + tk) * 512 + part * 128 : nullptr;
#pragma unroll 2
            for (int i = 0; i < 16; ++i) { const v4u rw = *(const v4u*)(src + 8 * i); const unsigned wv[4] = {rw.x, rw.y, rw.z, rw.w};
                const f32x4 g0 = *(const f32x4*)(lg + 8 * i), g1 = *(const f32x4*)(lg + 8 * i + 4), b0 = *(const f32x4*)(lb + 8 * i), b1 = *(const f32x4*)(lb + 8 * i + 4);
                float vv[8];
                const float gq[8] = {g0.x, g0.y, g0.z, g0.w, g1.x, g1.y, g1.z, g1.w}, bq[8] = {b0.x, b0.y, b0.z, b0.w, b1.x, b1.y, b1.z, b1.w};
#pragma unroll
                for (int e = 0; e < 4; ++e) { vv[2 * e] = (bflo(wv[e]) - mean) * rstd * gq[2 * e] + bq[2 * e]; vv[2 * e + 1] = (bfhi(wv[e]) - mean) * rstd * gq[2 * e + 1] + bq[2 * e + 1]; }
                if (vout) { *(f32x4*)(vout + 8 * i) = (f32x4){vv[0], vv[1], vv[2], vv[3]}; *(f32x4*)(vout + 8 * i + 4) = (f32x4){vv[4], vv[5], vv[6], vv[7]}; }
#pragma unroll
                for (int e = 0; e < 8; ++e) { const int c = part * 128 + 8 * i + e; *(LAS unsigned short*)(lds + c * VP + tk * 2) = (unsigned short)(cvt_pk_bf16(vv[e], 0.f) & 0xffffu); }
            }
        }
    }
    __syncthreads();
    { const int h = wave, half = lane >> 5, x = lane & 31;
        const float* W = a.in[23] + (size_t)h * 128 * 128; const float* BS = a.in[24] + h * 128;
        const int nit = ntok == 128 ? 4 : 1;
        for (int itile = 0; itile < nit; ++itile) {
            const int nks = ntok == 128 ? (itile < 2 ? 4 : 8) : 2;
            const int i = 32 * itile + x;
            f32x16 acc[2];
#pragma unroll
            for (int r = 0; r < 16; ++r) { acc[0][r] = 0.f; acc[1][r] = 0.f; }
            for (int ks = 0; ks < nks; ++ks) {
                const float* wp = W + (size_t)i * 128 + 16 * ks + 8 * half;
                const f32x4 w0 = *(const f32x4*)wp, w1 = *(const f32x4*)(wp + 4);
                v4u wb; wb.x = cvt_pk_bf16(w0.x, w0.y); wb.y = cvt_pk_bf16(w0.z, w0.w); wb.z = cvt_pk_bf16(w1.x, w1.y); wb.w = cvt_pk_bf16(w1.z, w1.w);
                const bf16x8 bfrag = __builtin_bit_cast(bf16x8, wb);
#pragma unroll
                for (int ct = 0; ct < 2; ++ct) { const bf16x8 af = *(const LAS bf16x8*)(lds + (h * 64 + 32 * ct + x) * VP + (16 * ks + 8 * half) * 2); acc[ct] = MFMA32(af, bfrag, acc[ct]); }
            }
            const float bsv = BS[i];
#pragma unroll
            for (int ct = 0; ct < 2; ++ct)
#pragma unroll
                for (int rq = 0; rq < 4; ++rq) { const int c0 = h * 64 + 32 * ct + 8 * rq + 4 * half;
                    const v2u uu = *(const v2u*)(UG + (size_t)(m0 + i) * 512 + c0);
                    const float o0 = bflo(uu.x) * (acc[ct][4 * rq + 0] + bsv), o1 = bfhi(uu.x) * (acc[ct][4 * rq + 1] + bsv), o2 = bflo(uu.y) * (acc[ct][4 * rq + 2] + bsv), o3 = bfhi(uu.y) * (acc[ct][4 * rq + 3] + bsv);
                    v2u w; w.x = cvt_pk_bf16(o0, o1); w.y = cvt_pk_bf16(o2, o3);
                    *(v2u*)(CAT + (size_t)(m0 + i) * 1024 + 512 + c0) = w; }
        }
    }
    __syncthreads();
}

__global__ void __launch_bounds__(512, 2) mega(Args a) {
    extern __shared__ __attribute__((aligned(16))) unsigned char lds_raw[];
    LAS unsigned char* lds = (LAS unsigned char*)lds_raw;
    cg::grid_group grid = cg::this_grid();
    const int tid = threadIdx.x, lane = tid & 63, wave = __builtin_amdgcn_readfirstlane(tid >> 6);
    const int G = gridDim.x, bx = blockIdx.x;
    const int vw = wave * G + bx, NGW = G * 8;
    const int lo = a.ph_lo, hi = a.ph_hi;
#ifndef PHMASK
#define PHMASK 0xfff
#endif
#define IN(k) ((((PHMASK) >> (k)) & 1) && lo <= (k) && (k) < hi)
#define SEAM(k) do { if (IN(k) && IN((k) + 1)) grid.sync(); } while (0)

    if (IN(0)) { p0_prologue(a, lds, vw, NGW, wave, lane); }
    SEAM(0);
    if (IN(1)) {
        float* modf = (float*)(a.ws + WS_MODF); const float* modp = (const float*)(a.ws + WS_MODP);
        for (int i = bx * 512 + tid; i < 9 * NMOD; i += G * 512) { float s = a.in[9][i % NMOD];
#pragma unroll
            for (int ks = 0; ks < 4; ++ks) s += modp[(size_t)ks * 9 * NMOD + i];
            modf[i] = s; }
        hprep<0>(a, vw, NGW, lane);
    }
    SEAM(1);
    if (IN(2)) {
        pg8::Gemm g{(const bf16*)(a.ws + WS_H), (const bf16*)(a.ws + WS_WIN), M, INW, D}; pg8::StaticOrder S; S.init(M, INW, G, bx);
        EpiIn E{(bf16*)(a.ws + WS_ZS5), (bf16*)(a.ws + WS_UG), (bf16*)(a.ws + WS_GV)};
        pg8::gemm_phase<EpiIn, pg8::StaticOrder, true, true>(lds, g, S, E);
    }
    SEAM(2);
    if (IN(3)) {
        for (int it = vw; it < 512 * 32; it += NGW) s5_item<false>(a, it & 31, it >> 5, lds + wave * 8704, lane);
    }
    SEAM(3);
    if (IN(4)) {
        for (int g = bx; g < 32; g += G) s5_chunk_scan(a, g, lds, tid);
        for (int it = (bx + G - 32) % G; it < 136; it += G) gmlp_item(a, it, lds, tid);
    }
    SEAM(4);
    if (IN(5)) {
        for (int it = vw; it < NCH * 32; it += NGW) s5_item<true>(a, it & 31, it >> 5, lds + wave * 8704, lane);
    }
    SEAM(5);
    if (IN(6)) {
        pg8::Gemm g{(const bf16*)(a.ws + WS_YS), (const bf16*)(a.ws + WS_WGLU), M, 512, 512}; pg8::StaticOrder S; S.init(M, 512, G, bx);
        EpiGlu E{(const bf16*)(a.ws + WS_YS), (bf16*)(a.ws + WS_CAT), a.in[20]};
        pg8::gemm_phase<EpiGlu, pg8::StaticOrder, true, true>(lds, g, S, E);
    }
    SEAM(6);
    if (IN(7)) {
        pg8::Gemm g{(const bf16*)(a.ws + WS_CAT), (const bf16*)(a.ws + WS_WOUT), M, D, D}; pg8::StaticOrder S; S.init(M, D, G, bx);
        EpiRes E{a.in[0], a.in[1], (const float*)(a.ws + WS_MODF) + 2 * D, (float*)(a.ws + WS_X1)};
        pg8::gemm_phase<EpiRes, pg8::StaticOrder, true, true>(lds, g, S, E);
    }
    SEAM(7);
    if (IN(8)) { hprep<1>(a, vw, NGW, lane); }
    SEAM(8);
    if (IN(9)) {
        pg8::Gemm g{(const bf16*)(a.ws + WS_H), (const bf16*)(a.ws + WS_WGU), M, GUW, D}; pg8::StaticOrder S; S.init(M, GUW, G, bx);
        EpiGU E{(bf16*)(a.ws + WS_HID)};
        pg8::gemm_phase<EpiGU, pg8::StaticOrder, true, true>(lds, g, S, E);
    }
    SEAM(9);
    if (IN(10)) {
        pg8::Gemm g{(const bf16*)(a.ws + WS_HID), (const bf16*)(a.ws + WS_WD), M, D, DFF}; pg8::StaticOrder S; S.init(M, D, G, bx);
        const float* x1 = (const float*)(a.ws + WS_X1);
        EpiRes E{x1, x1 + (size_t)SEQ * D, (const float*)(a.ws + WS_MODF) + 5 * D, a.out};
        pg8::gemm_phase<EpiRes, pg8::StaticOrder, true, true>(lds, g, S, E);
    }
    SEAM(10);
    if (IN(11)) {
        const float* fg = a.in[28];
        f32x4 gg[4];
#pragma unroll
        for (int j = 0; j < 4; ++j) gg[j] = *(const f32x4*)(fg + 4 * lane + 256 * j);
        for (int m = vw; m < M; m += NGW) { float* row = a.out + (size_t)m * D;
            f32x4 v[4]; float ss = 0.f;
#pragma unroll
            for (int j = 0; j < 4; ++j) { v[j] = *(const f32x4*)(row + 4 * lane + 256 * j); ss += (v[j].x * v[j].x + v[j].y * v[j].y) + (v[j].z * v[j].z + v[j].w * v[j].w); }
            const float rstd = 1.0f / sqrtf(wave_sum(ss) * (1.0f / D) + EPS);
#pragma unroll
            for (int j = 0; j < 4; ++j) *(f32x4*)(row + 4 * lane + 256 * j) = v[j] * rstd * gg[j]; }
    }
#undef IN
#undef SEAM
}

#ifndef MK_PER_PHASE
#define MK_PER_PHASE 0
#endif
extern "C" void kernel_launch(void* const* d_in, const int* in_sizes, int n_in, void* d_out, int out_size, void* d_ws, size_t ws_size, hipStream_t stream) {
    static int grid = 0;
    if (grid == 0) {
        int dev = 0, cus = 0, per_cu = 0;
        if (n_in != 29 || ws_size < WS_END) { fprintf(stderr, "kernel_launch: unexpected n_in %d / ws %zu\n", n_in, ws_size); grid = -1; return; }
        hipGetDevice(&dev); hipDeviceGetAttribute(&cus, hipDeviceAttributeMultiprocessorCount, dev);
        hipFuncSetAttribute((const void*)mega, hipFuncAttributeMaxDynamicSharedMemorySize, LDS_BYTES);
        hipOccupancyMaxActiveBlocksPerMultiprocessor(&per_cu, (const void*)mega, 512, LDS_BYTES);
        if (per_cu < 1) { fprintf(stderr, "kernel_launch: occupancy query says %d blocks/CU\n", per_cu); per_cu = 1; }
        (void)hipGetLastError();
        grid = cus * 1;
    }
    if (grid < 0) return;
    Args a{};
    for (int i = 0; i < 29; ++i) a.in[i] = (const float*)d_in[i];
    a.out = (float*)d_out; a.ws = (unsigned char*)d_ws;
#if MK_PER_PHASE
    for (int p = 0; p < NPH; ++p) { a.ph_lo = p; a.ph_hi = p + 1; hipLaunchKernelGGL(mega, dim3(grid), dim3(512), LDS_BYTES, stream, a); }
#else
    a.ph_lo = 0; a.ph_hi = NPH;
    void* args[] = {&a};
    hipError_t e = hipLaunchCooperativeKernel((const void*)mega, dim3(grid), dim3(512), args, LDS_BYTES, stream);
    if (e != hipSuccess) fprintf(stderr, "cooperative launch failed: %s (grid %d)\n", hipGetErrorString(e), grid);
#endif
}
```

```cpp
#include <hip/hip_runtime.h>
#include <hip/hip_cooperative_groups.h>
#include <cstdio>
#include <cstdint>
namespace cg = cooperative_groups;
namespace pg8 {
#define PG8_LAS __attribute__((address_space(3)))
typedef unsigned short bf16_t;
typedef short bf16x8 __attribute__((ext_vector_type(8)));
typedef float f32x4 __attribute__((ext_vector_type(4)));
typedef unsigned u32x4 __attribute__((ext_vector_type(4)));
constexpr int BM = 256, BK = 64, HALF = 128, HTB = HALF * BK * 2  , STAGE_BYTES = 8 * HTB, NXCD = 8, WGM = 8;

__host__ __device__ __forceinline__ int lds_byte(int r, int c) { const int st = (r >> 4) * 2 + (c >> 5), rr = r & 15, cc = c & 31, ob = rr * 64 + cc * 2; return st * 1024 + (ob ^ (((ob >> 9) & 1) << 5)); }
__host__ __device__ __forceinline__ void stage_rc(int b, int& R, int& C) { const int st = b / 1024, sb = b % 1024, swz = sb ^ (((sb >> 9) & 1) << 5); R = (st >> 1) * 16 + swz / 64; C = (st & 1) * 32 + (swz % 64) / 2; }
__host__ __device__ __forceinline__ int perm32(int rho) { const int n = rho >> 4, i = rho & 15; return 8 * (i >> 2) + 4 * n + (i & 3); }

struct Unit { int pm, pn; };
struct Gemm { const bf16_t* A; const bf16_t* Bt; int M, N, K; };

struct StaticOrder {
    int nM, nN, nwg, G, c;
    __host__ __device__ void init(int M, int N, int G_, int c_) { nM = M / BM; nN = N / BM; nwg = nM * nN; G = G_; c = c_; }
    __host__ __device__ bool next(int i, Unit& u) const {
        const long L = (long)i * G + c; if (L >= nwg) return false;
        int wgid = (int)L; { const int q = nwg / NXCD, r = nwg % NXCD, xcd = wgid % NXCD, off = wgid / NXCD; wgid = (xcd < r ? xcd * (q + 1) : r * (q + 1) + (xcd - r) * q) + off; }
        const int nig = WGM * nN, gid = wgid / nig, fm = gid * WGM, gsz = (nM - fm) < WGM ? (nM - fm) : WGM;
        u.pm = fm + ((wgid % nig) % gsz); u.pn = (wgid % nig) / gsz; return true;
    }
    __device__ __forceinline__ void a_ready(const Unit&) const {}
    __device__ __forceinline__ void done(const Unit&) const {}
};
__device__ __forceinline__ unsigned cvt_pk_bf16(float lo, float hi) { unsigned r; asm volatile("v_cvt_pk_bf16_f32 %0, %1, %2" : "=v"(r) : "v"(lo), "v"(hi)); return r; }
template <class Epi, class Sched, bool ALIGN_EPI = false, bool SP2 = false>
__device__ __forceinline__ void gemm_phase(PG8_LAS unsigned char* lds, const Gemm g, const Sched& S, const Epi& E) {
    const int tid = threadIdx.x, wid = __builtin_amdgcn_readfirstlane(tid >> 6), lane = tid & 63, wr = wid >> 2, wc = wid & 3, fr = lane & 15, fq = lane >> 4;
    const int K = g.K, nt = K / BK;
    unsigned voffA[2], voffB[2];
#pragma unroll
    for (int i = 0; i < 2; ++i) { int R, C; stage_rc(tid * 16 + i * 8192, R, C); const int Rb = Epi::PERM ? ((R & ~31) + perm32(R & 31)) : R;
        voffA[i] = (unsigned)(R * K + C) * 2u; voffB[i] = (unsigned)(Rb * K + C) * 2u; }
    const size_t kstep = (size_t)(BK * 2);
    const size_t hstep = (size_t)HALF * K * 2;
    const size_t tstep = 2 * hstep;
    const unsigned ldsw = (unsigned)wid * 1024u;
    const int aoff = lds_byte(wr * 64 + fr, fq * 8), boff = lds_byte(wc * 32 + fr, fq * 8);
#define PG8_SA(b, h) (((b) * 2 + (h)) * HTB)
#define PG8_SB(b, h) ((4 + (b) * 2 + (h)) * HTB)
#define PG8_STAGE(bufoff, gbase, voff) do { _Pragma("unroll") for (int _i = 0; _i < 2; ++_i) \
        __builtin_amdgcn_global_load_lds((const unsigned*)((const char*)(gbase) + (voff)[_i]), (PG8_LAS unsigned*)(lds + (bufoff) + ldsw + _i * 8192), 16, 0, 0); } while (0)
#define PG8_LDA(dst, b, h) do { _Pragma("unroll") for (int m = 0; m < 4; ++m) _Pragma("unroll") for (int k = 0; k < 2; ++k) dst[m][k] = *(const PG8_LAS bf16x8*)(lds + PG8_SA(b, h) + aoff + m * 2048 + k * 1024); } while (0)
#define PG8_LDB(dst, b, h) do { _Pragma("unroll") for (int n = 0; n < 2; ++n) _Pragma("unroll") for (int k = 0; k < 2; ++k) dst[n][k] = *(const PG8_LAS bf16x8*)(lds + PG8_SB(b, h) + boff + n * 2048 + k * 1024); } while (0)
#define PG8_MMA(ai, bj, At, Bt) do { __builtin_amdgcn_s_setprio(1); _Pragma("unroll") for (int m = 0; m < 4; ++m) _Pragma("unroll") for (int n = 0; n < 2; ++n) _Pragma("unroll") for (int k = 0; k < 2; ++k) \
        acc[ai][bj][m][n] = __builtin_amdgcn_mfma_f32_16x16x32_bf16(Bt[n][k], At[m][k], acc[ai][bj][m][n], 0, 0, 0); __builtin_amdgcn_s_setprio(0); } while (0)
#define PG8_WAIT_V(n) asm volatile("s_waitcnt vmcnt(" #n ")" ::: "memory")
#define PG8_WAIT_L(n) asm volatile("s_waitcnt lgkmcnt(" #n ")" ::: "memory")
#define PG8_BAR __builtin_amdgcn_s_barrier()
#define PG8_SCHED __builtin_amdgcn_sched_barrier(0)
    Unit cur, nxt; int ui = 0;
    if (!S.next(0, cur)) return;
    f32x4 acc[2][2][4][2];
#pragma unroll
    for (int a = 0; a < 2; ++a)
#pragma unroll
        for (int b = 0; b < 2; ++b)
#pragma unroll
            for (int m = 0; m < 4; ++m)
#pragma unroll
                for (int n = 0; n < 2; ++n) acc[a][b][m][n] = (f32x4){0.f, 0.f, 0.f, 0.f};
    bf16x8 At[4][2], B0[2][2], B1[2][2];
    const char* cA = (const char*)g.A + (size_t)cur.pm * tstep; const char* cB = (const char*)g.Bt + (size_t)cur.pn * tstep;
    S.a_ready(cur);
    if constexpr (SP2) {
        PG8_STAGE(PG8_SB(0, 0), cB, voffB); PG8_STAGE(PG8_SB(0, 1), cB + hstep, voffB); PG8_STAGE(PG8_SA(0, 0), cA, voffA); PG8_STAGE(PG8_SA(0, 1), cA + hstep, voffA);
        if (wr == 1) PG8_BAR;
        PG8_WAIT_V(2); PG8_BAR;
        PG8_STAGE(PG8_SB(1, 0), cB + kstep, voffB); PG8_STAGE(PG8_SA(1, 0), cA + kstep, voffA); PG8_STAGE(PG8_SB(1, 1), cB + hstep + kstep, voffB);
        PG8_WAIT_V(6); PG8_BAR;
    } else {
        PG8_STAGE(PG8_SB(0, 0), cB, voffB); PG8_STAGE(PG8_SA(0, 0), cA, voffA); PG8_STAGE(PG8_SB(0, 1), cB + hstep, voffB); PG8_STAGE(PG8_SA(0, 1), cA + hstep, voffA);
        if (wr == 1) PG8_BAR;
        PG8_WAIT_V(4); PG8_BAR;
        PG8_STAGE(PG8_SB(1, 0), cB + kstep, voffB); PG8_STAGE(PG8_SA(1, 0), cA + kstep, voffA); PG8_STAGE(PG8_SB(1, 1), cB + hstep + kstep, voffB);
        PG8_WAIT_V(6); PG8_BAR;
    }
    for (;;) {
        const bool has_next = S.next(ui + 1, nxt);
        const char* nA = has_next ? (const char*)g.A + (size_t)nxt.pm * tstep : cA; const char* nB = has_next ? (const char*)g.Bt + (size_t)nxt.pn * tstep : cB;
        for (int t = 0; t < nt; t += 2) {
            const bool last = (t == nt - 2);
            const char* a1 = cA + (size_t)(t + 1) * kstep;
            const char* a2 = last ? nA : cA + (size_t)(t + 2) * kstep; const char* b2 = last ? nB : cB + (size_t)(t + 2) * kstep;
            const char* a3 = a2 + kstep; const char* b3 = b2 + kstep;
            if (last && has_next) S.a_ready(nxt);
            if constexpr (SP2) {
            PG8_LDB(B0, 0, 0); PG8_LDB(B1, 0, 1); PG8_SCHED; PG8_LDA(At, 0, 0); PG8_STAGE(PG8_SA(1, 1), a1 + hstep, voffA);
            PG8_WAIT_V(8); PG8_WAIT_L(0); PG8_BAR; PG8_MMA(0, 0, At, B0); PG8_MMA(0, 1, At, B1); PG8_BAR; PG8_SCHED;
            PG8_LDA(At, 0, 1); PG8_STAGE(PG8_SB(0, 0), b2, voffB); PG8_STAGE(PG8_SB(0, 1), b2 + hstep, voffB); PG8_STAGE(PG8_SA(0, 0), a2, voffA);
            PG8_WAIT_V(8); PG8_WAIT_L(0); PG8_BAR; PG8_MMA(1, 0, At, B0); PG8_MMA(1, 1, At, B1); PG8_BAR; PG8_SCHED;
            PG8_LDB(B0, 1, 0); PG8_LDB(B1, 1, 1); PG8_SCHED; PG8_LDA(At, 1, 0); PG8_STAGE(PG8_SA(0, 1), a2 + hstep, voffA);
            PG8_WAIT_V(8); PG8_WAIT_L(0); PG8_BAR; PG8_MMA(0, 0, At, B0); PG8_MMA(0, 1, At, B1); PG8_BAR; PG8_SCHED;
            PG8_LDA(At, 1, 1); PG8_STAGE(PG8_SB(1, 0), b3, voffB); PG8_STAGE(PG8_SB(1, 1), b3 + hstep, voffB); PG8_STAGE(PG8_SA(1, 0), a3, voffA);
            PG8_WAIT_V(8); PG8_WAIT_L(0); PG8_BAR; PG8_MMA(1, 0, At, B0); PG8_MMA(1, 1, At, B1); PG8_BAR; PG8_SCHED;
            } else {
            PG8_LDB(B0, 0, 0); PG8_SCHED; PG8_LDA(At, 0, 0); PG8_STAGE(PG8_SA(1, 1), a1 + hstep, voffA);
            PG8_WAIT_L(8); PG8_BAR; PG8_WAIT_L(0); PG8_MMA(0, 0, At, B0); PG8_BAR; PG8_SCHED;
            PG8_LDB(B1, 0, 1); PG8_STAGE(PG8_SB(0, 0), b2, voffB);
            PG8_BAR; PG8_WAIT_L(0); PG8_MMA(0, 1, At, B1); PG8_BAR;
            PG8_LDA(At, 0, 1); PG8_STAGE(PG8_SA(0, 0), a2, voffA);
            PG8_BAR; PG8_WAIT_L(0); PG8_MMA(1, 0, At, B0); PG8_BAR; PG8_SCHED;
            PG8_STAGE(PG8_SB(0, 1), b2 + hstep, voffB);
            PG8_WAIT_V(6); PG8_BAR; PG8_MMA(1, 1, At, B1); PG8_BAR;
            PG8_LDB(B0, 1, 0); PG8_SCHED; PG8_LDA(At, 1, 0); PG8_STAGE(PG8_SA(0, 1), a2 + hstep, voffA);
            PG8_WAIT_L(8); PG8_BAR; PG8_WAIT_L(0); PG8_MMA(0, 0, At, B0); PG8_BAR; PG8_SCHED;
            PG8_LDB(B1, 1, 1); PG8_STAGE(PG8_SB(1, 0), b3, voffB);
            PG8_BAR; PG8_WAIT_L(0); PG8_MMA(0, 1, At, B1); PG8_BAR;
            PG8_LDA(At, 1, 1); PG8_STAGE(PG8_SA(1, 0), a3, voffA);
            PG8_BAR; PG8_WAIT_L(0); PG8_MMA(1, 0, At, B0); PG8_BAR; PG8_SCHED;
            PG8_STAGE(PG8_SB(1, 1), b3 + hstep, voffB);
            PG8_WAIT_V(6); PG8_BAR; PG8_MMA(1, 1, At, B1); PG8_BAR;
            }
        }
        if constexpr (ALIGN_EPI) { if (wr == 0) PG8_BAR; }
        if constexpr (!Epi::AFTER_DRAIN) { E(acc, cur, wr, wc, fr, fq); S.done(cur); }
        if (!has_next) break;
#pragma unroll
        for (int a = 0; a < 2; ++a)
#pragma unroll
            for (int b = 0; b < 2; ++b)
#pragma unroll
                for (int m = 0; m < 4; ++m)
#pragma unroll
                    for (int n = 0; n < 2; ++n) acc[a][b][m][n] = (f32x4){0.f, 0.f, 0.f, 0.f};
        cur = nxt; cA = nA; cB = nB; ++ui;
        if constexpr (ALIGN_EPI) { if (wr == 1) PG8_BAR; }
    }
    PG8_WAIT_V(0);
    if constexpr (!ALIGN_EPI) { if (wr == 0) PG8_BAR; }
    PG8_BAR;
    if constexpr (Epi::AFTER_DRAIN) { E.fused(acc, cur, wr, wc, fr, fq, lds, wid, lane); S.done(cur); }
#undef PG8_SA
#undef PG8_SB
#undef PG8_STAGE
#undef PG8_LDA
#undef PG8_LDB
#undef PG8_MMA
#undef PG8_WAIT_V
#undef PG8_WAIT_L
#undef PG8_BAR
#undef PG8_SCHED
}
}

#define GAS __attribute__((address_space(1)))
#define LAS __attribute__((address_space(3)))
typedef unsigned short bf16;
typedef unsigned v4u __attribute__((ext_vector_type(4)));
typedef unsigned v2u __attribute__((ext_vector_type(2)));
typedef float f32x4 __attribute__((ext_vector_type(4)));
typedef float f32x2 __attribute__((ext_vector_type(2)));
typedef float f32x16 __attribute__((ext_vector_type(16)));
typedef short bf16x8 __attribute__((ext_vector_type(8)));
using pg8::cvt_pk_bf16;

constexpr int D = 1024, SEQ = 16384, NSB = 8, NST = 32, M = SEQ + NSB * NST  , INW = 1536, DFF = 2816, GUW = 2 * DFF, NMOD = 6 * D;
constexpr int NCH = M / 32;
constexpr float EPS = 1e-6f;
constexpr size_t O_PRE = (size_t)M * D, O_PIM = O_PRE + 2048, O_SRE = O_PIM + 2048, O_SIM = O_SRE + 16384, O_V = O_SIM + 16384;

constexpr size_t MiB = 1u << 20, KiB = 1u << 10;
constexpr size_t WS_MODP = 240 * MiB;
constexpr int NKS = 16;
constexpr size_t WS_MODF = 2 * MiB;
constexpr size_t WS_TB = 2 * MiB + 512 * KiB;
constexpr size_t WS_TC = WS_TB + 128 * KiB;
constexpr size_t WS_TA = WS_TC + 128 * KiB;
constexpr size_t WS_TP = WS_TA + 64 * KiB;
constexpr size_t WS_WIN = 4 * MiB, WS_WGLU = 7 * MiB, WS_WOUT = 8 * MiB, WS_WGU = 10 * MiB, WS_WD = 21 * MiB;
constexpr size_t WS_SLOC = 27 * MiB, WS_SST = 35 * MiB;
constexpr size_t WS_H = 44 * MiB;
constexpr size_t WS_X1 = 77 * MiB;
constexpr size_t ACT5 = (size_t)M * 512 * 2;
constexpr size_t WS_ZS5 = 142 * MiB, WS_UG = WS_ZS5 + ACT5, WS_GV = WS_UG + ACT5, WS_YS = WS_GV + ACT5, WS_CAT = WS_YS + ACT5;
constexpr size_t WS_HID = 142 * MiB;
constexpr size_t WS_END = WS_CAT + (size_t)M * 1024 * 2;
static_assert(WS_END <= 256 * MiB && WS_HID + (size_t)M * DFF * 2 <= WS_END, "ws map");
constexpr int LDS_BYTES = 147456;
constexpr int NPH = 12;

__device__ __forceinline__ float bf2f(unsigned short b) { return __builtin_bit_cast(float, ((unsigned)b) << 16); }
__device__ __forceinline__ float bflo(unsigned w) { return __builtin_bit_cast(float, w << 16); }
__device__ __forceinline__ float bfhi(unsigned w) { return __builtin_bit_cast(float, w & 0xffff0000u); }
__device__ __forceinline__ float sigm(float x) { return __builtin_amdgcn_rcpf(1.f + __expf(-x)); }
__device__ __forceinline__ float gelu_t(float x) { const float z = 1.5957691216f * (x + 0.044715f * x * x * x); return x * sigm(z); }
__device__ __forceinline__ float silu_f(float x) { return x * sigm(x); }
__device__ __forceinline__ float wave_sum(float v) {
#pragma unroll
    for (int o = 1; o < 64; o <<= 1) v += __shfl_xor(v, o);
    return v;
}
#define LDS_WAIT() asm volatile("s_waitcnt lgkmcnt(0)" ::: "memory")

#define XB_TMO      128
#define XB_XCNT(j)  (256  + 64 * (j))
#define XB_XSUB(j)  (1280 + 64 * (j))
#define XB_XGEN(j)  (2304 + 64 * (j))
#define XB_TOP      3328
#define XB_TOPGEN   3392
#define XCD_BAR_WORDS 3456
#define XB_SPIN_CAP (1u << 18)

__device__ __forceinline__ unsigned xb_ld(unsigned* p)              { return __hip_atomic_load(p, __ATOMIC_RELAXED, __HIP_MEMORY_SCOPE_AGENT); }
__device__ __forceinline__ unsigned xb_add(unsigned* p, unsigned v) { return __hip_atomic_fetch_add(p, v, __ATOMIC_RELAXED, __HIP_MEMORY_SCOPE_AGENT); }
__device__ __forceinline__ unsigned xb_xcc_id() { return (unsigned)__builtin_amdgcn_s_getreg((3 << 11) | 20) & 0xFu; }
#define XB_SPIN(cond, bar) do { unsigned _sp = 0; while (cond) { __builtin_amdgcn_s_sleep(1); \
    if ((++_sp & 255u) == 0u) { if (xb_ld(&(bar)[XB_TMO])) break; if (_sp > XB_SPIN_CAP) { atomicAdd(&(bar)[XB_TMO], 1u); break; } } } } while (0)

struct XcdBarrier {
    unsigned* bar; unsigned x;
    volatile LAS unsigned* st;
};

__device__ __forceinline__ XcdBarrier xcd_barrier_post(unsigned* bar, volatile LAS unsigned* st) {
    XcdBarrier b; b.bar = bar; b.x = xb_xcc_id(); b.st = st;
    if (threadIdx.x == 0) (void)xb_add(&bar[XB_XCNT(b.x)], 1u);
    return b;
}
__device__ __forceinline__ void xcd_barrier_complete(unsigned* bar, unsigned x, unsigned& nloc, unsigned& nx) {
    const unsigned G = gridDim.x * gridDim.y * gridDim.z;
    unsigned sum, cnt, mine, sp = 0u;
    for (;;) {
        sum = 0u; cnt = 0u; mine = 0u;
#pragma unroll
        for (unsigned j = 0; j < 16; ++j) { const unsigned c = xb_ld(&bar[XB_XCNT(j)]); sum += c; cnt += (c > 0u) ? 1u : 0u; mine = (j == x) ? c : mine; }
        if (sum == G) break;
        __builtin_amdgcn_s_sleep(1);
        if ((++sp & 255u) == 0u) { if (xb_ld(&bar[XB_TMO])) break; if (sp > XB_SPIN_CAP) { atomicAdd(&bar[XB_TMO], 1u); break; } }
    }
    nloc = mine > 0u ? mine : 1u; nx = cnt > 0u ? cnt : 1u;
}

__device__ __forceinline__ void xcd_barrier(const XcdBarrier& b) {
    asm volatile("s_waitcnt vmcnt(0)" ::: "memory");
    __syncthreads();
    if (threadIdx.x == 0) {
        unsigned* bar = b.bar;
        __builtin_amdgcn_s_waitcnt(0);
        unsigned nloc = b.st[0], nx = b.st[1];
        if (nloc == 0u) { xcd_barrier_complete(bar, b.x, nloc, nx); b.st[0] = nloc; b.st[1] = nx; }
        const unsigned old = xb_add(&bar[XB_XSUB(b.x)], 1u);
        const unsigned gen = old / nloc;
        if (old + 1u == (gen + 1u) * nloc) {
            __builtin_amdgcn_fence(__ATOMIC_RELEASE, "agent");
            asm volatile("s_waitcnt vmcnt(0)" ::: "memory");
            const unsigned og = xb_add(&bar[XB_TOP], 1u);
            const unsigned tg = og / nx;
            if (og + 1u == (tg + 1u) * nx) xb_add(&bar[XB_TOPGEN], 1u);
            else XB_SPIN(xb_ld(&bar[XB_TOPGEN]) == tg, bar);
            __builtin_amdgcn_fence(__ATOMIC_ACQUIRE, "agent");
            xb_add(&bar[XB_XGEN(b.x)], 1u);
            asm volatile("s_waitcnt vmcnt(0)" ::: "memory");
        } else {
            XB_SPIN(xb_ld(&bar[XB_XGEN(b.x)]) == gen, bar);
            __builtin_amdgcn_fence(__ATOMIC_ACQUIRE, "agent");
            asm volatile("s_waitcnt vmcnt(0)" ::: "memory");
        }
    }
    __syncthreads();
}

struct Args { const float* in[29]; float* out; unsigned char* ws; int ph_lo, ph_hi; };

__device__ __forceinline__ void p0_transpose_item(const float* W, int K, int N, bf16* WT, int dst_row0, LAS float* scr, int kb, int nb, int lane) {
    const int k0 = 64 * kb, n0 = 32 * nb;
#pragma unroll
    for (int i = 0; i < 32; ++i) { const int kk = 2 * i + (lane >> 5); scr[kk * 33 + (lane & 31)] = W[(size_t)(k0 + kk) * N + n0 + (lane & 31)]; }
    LDS_WAIT();
    const int c = lane & 7;
#pragma unroll
    for (int j = 0; j < 4; ++j) { const int n = (lane >> 3) + 8 * j; const LAS float* s = scr + (8 * c) * 33 + n;
        v4u o; o.x = cvt_pk_bf16(s[0 * 33], s[1 * 33]); o.y = cvt_pk_bf16(s[2 * 33], s[3 * 33]); o.z = cvt_pk_bf16(s[4 * 33], s[5 * 33]); o.w = cvt_pk_bf16(s[6 * 33], s[7 * 33]);
        *(v4u*)(WT + (size_t)(dst_row0 + n) * K + k0 + 8 * c) = o; }
    LDS_WAIT();
}
__device__ __forceinline__ float rl(float v, int l) { return __builtin_bit_cast(float, __builtin_amdgcn_readlane(__builtin_bit_cast(int, v), l)); }

__device__ __forceinline__ void p0_ada_item(const Args& a, int cs, int ks, int lane) {
    const float* cp = a.in[4]; const float* csm = a.in[5]; const float* W = a.in[8];
    float* modp = (float*)(a.ws + WS_MODP);
    const int c0 = cs * 256 + 4 * lane, k0 = ks * 64;
    float sl[9];
#pragma unroll
    for (int b = 0; b < 9; ++b) { const int k = k0 + lane; const float cv = (b == 0) ? cp[k] : csm[(b - 1) * D + k]; sl[b] = silu_f(cv); }
    f32x4 acc[9];
#pragma unroll
    for (int b = 0; b < 9; ++b) acc[b] = (f32x4){0.f, 0.f, 0.f, 0.f};
#pragma unroll 16
    for (int kk = 0; kk < 64; ++kk) {
        const f32x4 w = *(const f32x4*)(W + (size_t)(k0 + kk) * NMOD + c0);
#pragma unroll
        for (int b = 0; b < 9; ++b) { const float s = rl(sl[b], kk); acc[b] += w * s; }
    }
#pragma unroll
    for (int b = 0; b < 9; ++b) *(f32x4*)(modp + ((size_t)ks * 9 + b) * NMOD + c0) = acc[b];
}

__device__ __forceinline__ void p0_s5_tables(const Args& a, int g, int lane) {
    const int n = lane;
    const float step = expf(a.in[13][g]);
    const float lr = a.in[11][g * 64 + n], li = a.in[12][g * 64 + n];
    const float x = lr * step, y = li * step;
    const float ex = expf(x), cy = cosf(y), sy = sinf(y), sh = sinf(0.5f * y);
    const float a1r = ex * cy, a1i = ex * sy;
    const float mr = expm1f(x) * cy - 2.f * sh * sh, mi = ex * sy;
    const float den = lr * lr + li * li;
    const float fr = (mr * lr + mi * li) / den, fi = (mi * lr - mr * li) / den;
    bf16* TB = (bf16*)(a.ws + WS_TB); bf16* TC = (bf16*)(a.ws + WS_TC); float* TA = (float*)(a.ws + WS_TA); float* TP = (float*)(a.ws + WS_TP);
    const float* br = a.in[14] + (size_t)(g * 64 + n) * 16; const float* bi = a.in[15] + (size_t)(g * 64 + n) * 16;
    const int xx = n >> 1, sbit = n & 1;
    bf16* rowre = TB + (size_t)(g * 128 + (0 + sbit) * 32 + xx) * 16;
    bf16* rowim = TB + (size_t)(g * 128 + (2 + sbit) * 32 + xx) * 16;
#pragma unroll
    for (int q = 0; q < 16; q += 2) {
        const float b0r = br[q], b0i = bi[q], b1r = br[q + 1], b1i = bi[q + 1];
        *(unsigned*)(rowre + q) = cvt_pk_bf16(fr * b0r - fi * b0i, fr * b1r - fi * b1i);
        *(unsigned*)(rowim + q) = cvt_pk_bf16(fr * b0i + fi * b0r, fr * b1i + fi * b1r);
    }
    double pr = a1r, pi = a1i;
    double p2r = pr * pr - pi * pi, p2i = 2.0 * pr * pi;
    double p3r = p2r * pr - p2i * pi, p3i = p2r * pi + p2i * pr;
    double p4r = p2r * p2r - p2i * p2i, p4i = 2.0 * p2r * p2i;
    float* ta = TA + (size_t)(g * 64 + n) * 8;
    ta[0] = (float)pr; ta[1] = (float)pi; ta[2] = (float)p2r; ta[3] = (float)p2i; ta[4] = (float)p3r; ta[5] = (float)p3i; ta[6] = (float)p4r; ta[7] = (float)p4i;
    double qr = p4r, qi = p4i;
#pragma unroll
    for (int s = 0; s < 3; ++s) { const double t = qr * qr - qi * qi; qi = 2.0 * qr * qi; qr = t; }
    float* tp = TP + (size_t)(g * 64 + n) * 4;
    tp[0] = (float)qr; tp[1] = (float)qi;
#pragma unroll
    for (int s = 0; s < 6; ++s) { const double t = qr * qr - qi * qi; qi = 2.0 * qr * qi; qr = t; }
    tp[2] = (float)qr; tp[3] = (float)qi;
    const float* cr = a.in[16] + (size_t)g * 16 * 64; const float* ci = a.in[17] + (size_t)g * 16 * 64;
#pragma unroll
    for (int p = 0; p < 16; ++p) { TC[(size_t)(g * 16 + p) * 128 + n] = (bf16)(cvt_pk_bf16(cr[p * 64 + n], 0.f) & 0xffffu); TC[(size_t)(g * 16 + p) * 128 + 64 + n] = (bf16)(cvt_pk_bf16(-ci[p * 64 + n], 0.f) & 0xffffu); }
}

__device__ __forceinline__ void p0_prologue(const Args& a, LAS unsigned char* lds, int vw, int NGW, int wave, int lane) {
    LAS float* scr = (LAS float*)(lds + wave * 16384);
    constexpr int I_ADA = 24 * NKS, I_S5 = 32, I_IN = 16 * 48, I_GLU = 8 * 16, I_OUT = 16 * 32, I_GU = 16 * 176, I_D = 44 * 32;
    constexpr int NITEMS = I_ADA + I_S5 + I_IN + I_GLU + I_OUT + I_GU + I_D;
    for (int it = vw; it < NITEMS; it += NGW) {
        int r = it;
        if (r < I_ADA) { p0_ada_item(a, r % 24, r / 24, lane); continue; } r -= I_ADA;
        if (r < I_S5) { p0_s5_tables(a, r, lane); continue; } r -= I_S5;
        if (r < I_IN) { const int nblk = INW / 32, kb = r / nblk, nb = r % nblk; p0_transpose_item(a.in[10], D, INW, (bf16*)(a.ws + WS_WIN), 32 * nb, scr, kb, nb, lane); continue; } r -= I_IN;
        if (r < I_GLU) { const int nblk = 16, kb = r / nblk, nb = r % nblk; p0_transpose_item(a.in[19], 512, 512, (bf16*)(a.ws + WS_WGLU), 32 * nb, scr, kb, nb, lane); continue; } r -= I_GLU;
        if (r < I_OUT) { const int nblk = 32, kb = r / nblk, nb = r % nblk; p0_transpose_item(a.in[25], D, D, (bf16*)(a.ws + WS_WOUT), 32 * nb, scr, kb, nb, lane); continue; } r -= I_OUT;
        if (r < I_GU) { const int nblk = GUW / 32, kb = r / nblk, nb = r % nblk; const int n0 = 32 * nb; const int j = n0 < DFF ? n0 : n0 - DFF;
            const int drow = 256 * (j >> 7) + (n0 < DFF ? 0 : 128) + (j & 127);
            p0_transpose_item(a.in[26], D, GUW, (bf16*)(a.ws + WS_WGU), drow, scr, kb, nb, lane); continue; } r -= I_GU;
        { const int nblk = 32, kb = r / nblk, nb = r % nblk; p0_transpose_item(a.in[27], DFF, D, (bf16*)(a.ws + WS_WD), 32 * nb, scr, kb, nb, lane); }
    }
}

template <int WHICH>
__device__ __forceinline__ void hprep(const Args& a, int vw, int NGW, int lane) {
    const float* gvec = a.in[WHICH == 0 ? 6 : 7];
    const float* modp = (const float*)(a.ws + WS_MODP); const float* modf = (const float*)(a.ws + WS_MODF); const float* bada = a.in[9];
    bf16* H = (bf16*)(a.ws + WS_H);
    const int soff = WHICH == 0 ? 0 : 3 * D, coff = soff + D;
    int cur = -1; f32x4 ca[4], cb[4], vn[4];
    if (vw < M) { const float* xr0 = WHICH == 0 ? (vw < SEQ ? a.in[0] + (size_t)vw * D : a.in[1] + (size_t)(vw - SEQ) * D) : (const float*)(a.ws + WS_X1) + (size_t)vw * D;
#pragma unroll
        for (int j = 0; j < 4; ++j) vn[j] = *(const f32x4*)(xr0 + 4 * lane + 256 * j); }
    for (int m = vw; m < M; m += NGW) {
        const int mr = m < SEQ ? 0 : 1 + ((m - SEQ) >> 5);
        if (mr != cur) { cur = mr;
#pragma unroll
            for (int j = 0; j < 4; ++j) { const int k = 4 * lane + 256 * j; f32x4 sc, sh;
                if (WHICH == 0) { sc = *(const f32x4*)(bada + coff + k); sh = *(const f32x4*)(bada + soff + k);
#pragma unroll
                    for (int ks = 0; ks < NKS; ++ks) { sc += *(const f32x4*)(modp + ((size_t)ks * 9 + mr) * NMOD + coff + k); sh += *(const f32x4*)(modp + ((size_t)ks * 9 + mr) * NMOD + soff + k); } }
                else { sc = *(const f32x4*)(modf + (size_t)mr * NMOD + coff + k); sh = *(const f32x4*)(modf + (size_t)mr * NMOD + soff + k); }
                const f32x4 gg = *(const f32x4*)(gvec + k); ca[j] = gg * (sc + 1.0f); cb[j] = sh; } }
        f32x4 v[4]; float ss = 0.f;
#pragma unroll
        for (int j = 0; j < 4; ++j) v[j] = vn[j];
        { const int m2 = m + NGW; if (m2 < M) { const float* xr2 = WHICH == 0 ? (m2 < SEQ ? a.in[0] + (size_t)m2 * D : a.in[1] + (size_t)(m2 - SEQ) * D) : (const float*)(a.ws + WS_X1) + (size_t)m2 * D;
#pragma unroll
            for (int j = 0; j < 4; ++j) vn[j] = *(const f32x4*)(xr2 + 4 * lane + 256 * j); } }
#pragma unroll
        for (int j = 0; j < 4; ++j) ss += (v[j].x * v[j].x + v[j].y * v[j].y) + (v[j].z * v[j].z + v[j].w * v[j].w);
        const float rstd = 1.0f / sqrtf(wave_sum(ss) * (1.0f / D) + EPS);
#pragma unroll
        for (int j = 0; j < 4; ++j) { const f32x4 o = v[j] * rstd * ca[j] + cb[j]; v2u w; w.x = cvt_pk_bf16(o.x, o.y); w.y = cvt_pk_bf16(o.z, o.w);
            *(v2u*)(H + (size_t)m * D + 4 * lane + 256 * j) = w; }
    }
}

using pg8::Unit;
struct EpiIn {
    static constexpr bool PERM = true, AFTER_DRAIN = false;
    bf16 *zs5, *ug, *gv;
    __device__ __forceinline__ void operator()(const f32x4 (&acc)[2][2][4][2], const Unit& u, int wr, int wc, int fr, int fq) const {
        const int sec = u.pn >> 1; bf16* base = zs5 + (size_t)sec * (ACT5 / 2);
        const int row0 = u.pm * 256 + wr * 64 + fr, col0 = (u.pn & 1) * 256 + wc * 32 + 8 * fq;
#pragma unroll
        for (int ai = 0; ai < 2; ++ai)
#pragma unroll
            for (int m = 0; m < 4; ++m) { bf16* rowp = base + (size_t)(row0 + ai * 128 + m * 16) * 512 + col0;
#pragma unroll
                for (int bj = 0; bj < 2; ++bj) { const f32x4 v0 = acc[ai][bj][m][0], v1 = acc[ai][bj][m][1];
                    v4u w;
                    if (sec) { w.x = cvt_pk_bf16(gelu_t(v0.x), gelu_t(v0.y)); w.y = cvt_pk_bf16(gelu_t(v0.z), gelu_t(v0.w)); w.z = cvt_pk_bf16(gelu_t(v1.x), gelu_t(v1.y)); w.w = cvt_pk_bf16(gelu_t(v1.z), gelu_t(v1.w)); }
                    else { w.x = cvt_pk_bf16(v0.x, v0.y); w.y = cvt_pk_bf16(v0.z, v0.w); w.z = cvt_pk_bf16(v1.x, v1.y); w.w = cvt_pk_bf16(v1.z, v1.w); }
                    *(v4u*)(rowp + bj * 128) = w; }
                asm volatile("" ::: "memory"); }
    }
};
struct EpiGlu {
    static constexpr bool PERM = true, AFTER_DRAIN = false;
    const bf16* ys; bf16* cat; const float* bias;
    __device__ __forceinline__ void operator()(const f32x4 (&acc)[2][2][4][2], const Unit& u, int wr, int wc, int fr, int fq) const {
        const int row0 = u.pm * 256 + wr * 64 + fr, col0 = u.pn * 256 + wc * 32 + 8 * fq;
        f32x4 bv[2][2];
#pragma unroll
        for (int bj = 0; bj < 2; ++bj)
#pragma unroll
            for (int n = 0; n < 2; ++n) bv[bj][n] = *(const f32x4*)(bias + col0 + bj * 128 + 4 * n);
#pragma unroll
        for (int ai = 0; ai < 2; ++ai)
#pragma unroll
            for (int m = 0; m < 4; ++m) { const size_t r = (size_t)(row0 + ai * 128 + m * 16);
#pragma unroll
                for (int bj = 0; bj < 2; ++bj) { const f32x4 g0 = acc[ai][bj][m][0] + bv[bj][0], g1 = acc[ai][bj][m][1] + bv[bj][1];
                    const v4u y = *(const v4u*)(ys + r * 512 + col0 + bj * 128);
                    v4u w;
                    w.x = cvt_pk_bf16(bflo(y.x) * sigm(g0[0]), bfhi(y.x) * sigm(g0[1])); w.y = cvt_pk_bf16(bflo(y.y) * sigm(g0[2]), bfhi(y.y) * sigm(g0[3]));
                    w.z = cvt_pk_bf16(bflo(y.z) * sigm(g1[0]), bfhi(y.z) * sigm(g1[1])); w.w = cvt_pk_bf16(bflo(y.w) * sigm(g1[2]), bfhi(y.w) * sigm(g1[3]));
                    *(v4u*)(cat + r * 1024 + col0 + bj * 128) = w; } }
    }
};
struct EpiRes {
    static constexpr bool PERM = false, AFTER_DRAIN = false;
    const float* bp; const float* bs; const float* gate  ; float* out;
    __device__ __forceinline__ void operator()(const f32x4 (&acc)[2][2][4][2], const Unit& u, int wr, int wc, int fr, int fq) const {
        const int col0 = u.pn * 256 + wc * 32 + 4 * fq;
#pragma unroll
        for (int ai = 0; ai < 2; ++ai)
#pragma unroll
            for (int m = 0; m < 4; ++m) { const int rl_ = ai * 128 + wr * 64 + m * 16 + fr; const int row = u.pm * 256 + rl_;
                const float* brow = row < SEQ ? bp + (size_t)row * D : bs + (size_t)(row - SEQ) * D;
                const int mr = row < SEQ ? 0 : 1 + ((row - SEQ) >> 5);
                const float* grow = gate + (size_t)mr * NMOD;
#pragma unroll
                for (int bj = 0; bj < 2; ++bj)
#pragma unroll
                    for (int n = 0; n < 2; ++n) { const int c = col0 + bj * 128 + n * 16;
                        const f32x4 b = *(const f32x4*)(brow + c), g = *(const f32x4*)(grow + c);
                        *(f32x4*)(out + (size_t)row * D + c) = b + g * acc[ai][bj][m][n]; }
                asm volatile("" ::: "memory"); }
    }
};
struct EpiGU {
    static constexpr bool PERM = true, AFTER_DRAIN = false;
    bf16* hid;
    __device__ __forceinline__ void operator()(const f32x4 (&acc)[2][2][4][2], const Unit& u, int wr, int wc, int fr, int fq) const {
        const int row0 = u.pm * 256 + wr * 64 + fr, col0 = u.pn * 128 + wc * 32 + 8 * fq;
#pragma unroll
        for (int ai = 0; ai < 2; ++ai)
#pragma unroll
            for (int m = 0; m < 4; ++m) { bf16* rowp = hid + (size_t)(row0 + ai * 128 + m * 16) * DFF + col0;
                const f32x4 g0 = acc[ai][0][m][0], g1 = acc[ai][0][m][1], u0 = acc[ai][1][m][0], u1 = acc[ai][1][m][1];
                v4u w; w.x = cvt_pk_bf16(silu_f(g0[0]) * u0[0], silu_f(g0[1]) * u0[1]); w.y = cvt_pk_bf16(silu_f(g0[2]) * u0[2], silu_f(g0[3]) * u0[3]);
                w.z = cvt_pk_bf16(silu_f(g1[0]) * u1[0], silu_f(g1[1]) * u1[1]); w.w = cvt_pk_bf16(silu_f(g1[2]) * u1[2], silu_f(g1[3]) * u1[3]);
                *(v4u*)rowp = w; }
    }
};

#define MFMA32(a, b, c) __builtin_amdgcn_mfma_f32_32x32x16_bf16((a), (b), (c), 0, 0, 0)
#define MFMA16(a, b, c) __builtin_amdgcn_mfma_f32_16x16x32_bf16((a), (b), (c), 0, 0, 0)
template <bool FULL>
__device__ __forceinline__ void s5_phase(const Args& a, LAS unsigned char* sbuf, int vw, int NGW, int lane, int nitems) {
    const int half = lane >> 5, x = lane & 31, l15 = lane & 15, q4 = lane >> 4;
    const bf16* ZS5 = (const bf16*)(a.ws + WS_ZS5);
    const bf16* TB = (const bf16*)(a.ws + WS_TB); const float* TA = (const float*)(a.ws + WS_TA); const bf16* TC = (const bf16*)(a.ws + WS_TC);
    bf16* YS = (bf16*)(a.ws + WS_YS);
    int curg = -1;
    bf16x8 tb[4], tc[4]; f32x4 ta[2][2]; f32x4 dd;
    int it = vw; if (it >= nitems) return;
    bf16x8 un = *(const bf16x8*)(ZS5 + (size_t)((it >> 5) * 32 + x) * 512 + (it & 31) * 16 + half * 8);
    for (; it < nitems; it += NGW) {
        const int g = it & 31, ch = it >> 5, m0 = ch * 32;
        if (g != curg) { curg = g;
#pragma unroll
            for (int c = 0; c < 4; ++c) tb[c] = *(const bf16x8*)(TB + (size_t)(g * 128 + c * 32 + x) * 16 + half * 8);
#pragma unroll
            for (int s = 0; s < 2; ++s) { ta[s][0] = *(const f32x4*)(TA + (size_t)(g * 64 + 2 * x + s) * 8); ta[s][1] = *(const f32x4*)(TA + (size_t)(g * 64 + 2 * x + s) * 8 + 4); }
            if (FULL) {
#pragma unroll
                for (int ks = 0; ks < 4; ++ks) tc[ks] = *(const bf16x8*)(TC + (size_t)(g * 16 + l15) * 128 + ks * 32 + q4 * 8);
                dd = *(const f32x4*)(a.in[18] + g * 16 + q4 * 4); }
        }
        const bf16x8 ua = un;
        { const int nx = it + NGW; if (nx < nitems) un = *(const bf16x8*)(ZS5 + (size_t)((nx >> 5) * 32 + x) * 512 + (nx & 31) * 16 + half * 8); }
        float cin0r = 0.f, cin0i = 0.f, cin1r = 0.f, cin1i = 0.f;
        if (FULL) {
            if (ch >= 512) { const int b = ch - 512; const f32x2 r2 = *(const f32x2*)(a.in[2] + (size_t)(b * 32 + g) * 64 + 2 * x), i2 = *(const f32x2*)(a.in[3] + (size_t)(b * 32 + g) * 64 + 2 * x);
                cin0r = r2.x; cin1r = r2.y; cin0i = i2.x; cin1i = i2.y; }
            else if (ch > 0) { const float* sst = (const float*)(a.ws + WS_SST) + (size_t)(ch * 32 + g) * 128; const f32x2 r2 = *(const f32x2*)(sst + 2 * x), i2 = *(const f32x2*)(sst + 64 + 2 * x);
                cin0r = r2.x; cin1r = r2.y; cin0i = i2.x; cin1i = i2.y; }
        }
        v2u uu[2];
        if (FULL) {
#pragma unroll
            for (int tt = 0; tt < 2; ++tt) uu[tt] = *(const v2u*)(ZS5 + (size_t)(m0 + tt * 16 + l15) * 512 + g * 16 + q4 * 4); }
        f32x16 acc[4];
#pragma unroll
        for (int c = 0; c < 4; ++c) { f32x16 z;
#pragma unroll
            for (int r = 0; r < 16; ++r) z[r] = 0.f;
            acc[c] = MFMA32(ua, tb[c], z); }
        float endr[2], endi[2];
#pragma unroll
        for (int s = 0; s < 2; ++s) {
            const f32x4 t0 = ta[s][0], t1 = ta[s][1];
            const float apr[4] = {t0.x, t0.z, t1.x, t1.z}, api[4] = {t0.y, t0.w, t1.y, t1.w};
            const float a1r = apr[0], a1i = api[0], a4r = apr[3], a4i = api[3];
            f32x16& R = acc[s]; f32x16& I = acc[2 + s];
#pragma unroll
            for (int i = 0; i < 4; ++i)
#pragma unroll
                for (int j = 1; j < 4; ++j) { const int r = 4 * i + j; const float pr = R[r - 1], pi = I[r - 1];
                    R[r] += a1r * pr - a1i * pi; I[r] += a1r * pi + a1i * pr; }
            float cr = s ? cin1r : cin0r, ci = s ? cin1i : cin0i;
            float cinr[4], cini[4];
#pragma unroll
            for (int i = 0; i < 4; ++i) {
                const float lr_ = R[4 * i + 3], li_ = I[4 * i + 3];
                const float candr = a4r * cr - a4i * ci + lr_, candi = a4r * ci + a4i * cr + li_;
                const float othr = __shfl_xor(candr, 32), othi = __shfl_xor(candi, 32);
                cinr[i] = half ? othr : cr; cini[i] = half ? othi : ci;
                const float outr = a4r * cinr[i] - a4i * cini[i] + lr_, outi = a4r * cini[i] + a4i * cinr[i] + li_;
                cr = __shfl_xor(outr, 32); ci = __shfl_xor(outi, 32);
            }
            endr[s] = cr; endi[s] = ci;
            if (FULL) {
#pragma unroll
                for (int i = 0; i < 4; ++i)
#pragma unroll
                    for (int j = 0; j < 4; ++j) { const int r = 4 * i + j;
                        R[r] += apr[j] * cinr[i] - api[j] * cini[i]; I[r] += apr[j] * cini[i] + api[j] * cinr[i]; }
            }
        }
        if (!FULL) {
            if (half == 0) { float* sl = (float*)(a.ws + WS_SLOC) + (size_t)(ch * 32 + g) * 128;
                *(f32x2*)(sl + 2 * x) = (f32x2){endr[0], endr[1]}; *(f32x2*)(sl + 64 + 2 * x) = (f32x2){endi[0], endi[1]}; }
            continue;
        }
        if (half == 0 && ch >= 511) {
            float* ore = ch == 511 ? a.out + O_PRE + g * 64 : a.out + O_SRE + (size_t)((ch - 512) * 32 + g) * 64;
            float* oim = ch == 511 ? a.out + O_PIM + g * 64 : a.out + O_SIM + (size_t)((ch - 512) * 32 + g) * 64;
            *(f32x2*)(ore + 2 * x) = (f32x2){endr[0], endr[1]}; *(f32x2*)(oim + 2 * x) = (f32x2){endi[0], endi[1]};
        }
#pragma unroll
        for (int r = 0; r < 16; ++r) { const int t = (r & 3) + 8 * (r >> 2) + 4 * half;
            *(LAS unsigned*)(sbuf + t * 272 + 4 * x) = cvt_pk_bf16(acc[0][r], acc[1][r]);
            *(LAS unsigned*)(sbuf + t * 272 + 128 + 4 * x) = cvt_pk_bf16(acc[2][r], acc[3][r]); }
        LDS_WAIT();
        f32x4 y[2] = {(f32x4){0.f, 0.f, 0.f, 0.f}, (f32x4){0.f, 0.f, 0.f, 0.f}};
#pragma unroll
        for (int ks = 0; ks < 4; ++ks) {
#pragma unroll
            for (int tt = 0; tt < 2; ++tt) { const bf16x8 sb = *(const LAS bf16x8*)(sbuf + (tt * 16 + l15) * 272 + (ks * 32 + q4 * 8) * 2); y[tt] = MFMA16(tc[ks], sb, y[tt]); } }
        LDS_WAIT();
#pragma unroll
        for (int tt = 0; tt < 2; ++tt) { const size_t off = (size_t)(m0 + tt * 16 + l15) * 512 + g * 16 + q4 * 4;
            const float o0 = gelu_t(y[tt][0] + dd[0] * bflo(uu[tt].x)), o1 = gelu_t(y[tt][1] + dd[1] * bfhi(uu[tt].x)), o2 = gelu_t(y[tt][2] + dd[2] * bflo(uu[tt].y)), o3 = gelu_t(y[tt][3] + dd[3] * bfhi(uu[tt].y));
            v2u w; w.x = cvt_pk_bf16(o0, o1); w.y = cvt_pk_bf16(o2, o3); *(v2u*)(YS + off) = w; }
    }
}

__device__ __forceinline__ void s5_chunk_scan(const Args& a, int g, LAS unsigned char* lds, int tid) {
    const int n = tid & 63, seg = tid >> 6;
    const float* TP = (const float*)(a.ws + WS_TP) + (size_t)(g * 64 + n) * 4;
    const float pr = TP[0], pi = TP[1], qr = TP[2], qi = TP[3];
    const float* sl = (const float*)(a.ws + WS_SLOC) + (size_t)(seg * 64) * 4096 + g * 128 + n;
    float* st = (float*)(a.ws + WS_SST) + (size_t)(seg * 64) * 4096 + g * 128 + n;
    float vr = 0.f, vi = 0.f;
#pragma unroll 8
    for (int k = 0; k < 64; ++k) { const float lr_ = sl[(size_t)k * 4096], li_ = sl[(size_t)k * 4096 + 64]; const float t = pr * vr - pi * vi + lr_; vi = pr * vi + pi * vr + li_; vr = t; }
    LAS f32x2* agg = (LAS f32x2*)lds;
    agg[seg * 64 + n] = (f32x2){vr, vi};
    __syncthreads();
    float cr = 0.f, ci = 0.f;
    for (int s = 0; s < seg; ++s) { const f32x2 ag = agg[s * 64 + n]; const float t = qr * cr - qi * ci + ag.x; ci = qr * ci + qi * cr + ag.y; cr = t; }
    vr = cr; vi = ci;
#pragma unroll 8
    for (int k = 0; k < 64; ++k) { st[(size_t)k * 4096] = vr; st[(size_t)k * 4096 + 64] = vi;
        const float lr_ = sl[(size_t)k * 4096], li_ = sl[(size_t)k * 4096 + 64]; const float t = pr * vr - pi * vi + lr_; vi = pr * vi + pi * vr + li_; vr = t; }
    __syncthreads();
}

__device__ __forceinline__ void gmlp_item(const Args& a, int it, LAS unsigned char* lds, int tid) {
    const int lane = tid & 63, wave = tid >> 6;
    const int m0 = it < 128 ? it * 128 : SEQ + (it - 128) * 32, ntok = it < 128 ? 128 : 32;
    const bf16* GV = (const bf16*)(a.ws + WS_GV); const bf16* UG = (const bf16*)(a.ws + WS_UG); bf16* CAT = (bf16*)(a.ws + WS_CAT);
    constexpr int VP = 272;
    { const int tk = tid >> 2, part = tid & 3;
        if (tk < ntok) {
            const bf16* src = GV + (size_t)(m0 + tk) * 512 + part * 128;
            float s = 0.f, q = 0.f;
#pragma unroll 4
            for (int i = 0; i < 16; ++i) { const v4u rw = *(const v4u*)(src + 8 * i); const unsigned wv[4] = {rw.x, rw.y, rw.z, rw.w};
#pragma unroll
                for (int e = 0; e < 4; ++e) { const float d0 = bflo(wv[e]), d1 = bfhi(wv[e]); s += d0 + d1; q += d0 * d0 + d1 * d1; } }
            s += __shfl_xor(s, 1); s += __shfl_xor(s, 2); q += __shfl_xor(q, 1); q += __shfl_xor(q, 2);
            const float mean = s * (1.0f / 512.0f);
            const float rstd = 1.0f / sqrtf(fmaxf(q * (1.0f / 512.0f) - mean * mean, 0.f) + EPS);
            const float* lg = a.in[21] + part * 128; const float* lb = a.in[22] + part * 128;
            float* vout = (it >= 128) ? a.out + O_V + (size_t)((it - 128) * 32 + tk) * 512 + part * 128 : nullptr;
#pragma unroll 2
            for (int i = 0; i < 16; ++i) { const v4u rw = *(const v4u*)(src + 8 * i); const unsigned wv[4] = {rw.x, rw.y, rw.z, rw.w};
                const f32x4 g0 = *(const f32x4*)(lg + 8 * i), g1 = *(const f32x4*)(lg + 8 * i + 4), b0 = *(const f32x4*)(lb + 8 * i), b1 = *(const f32x4*)(lb + 8 * i + 4);
                float vv[8];
                const float gq[8] = {g0.x, g0.y, g0.z, g0.w, g1.x, g1.y, g1.z, g1.w}, bq[8] = {b0.x, b0.y, b0.z, b0.w, b1.x, b1.y, b1.z, b1.w};
#pragma unroll
                for (int e = 0; e < 4; ++e) { vv[2 * e] = (bflo(wv[e]) - mean) * rstd * gq[2 * e] + bq[2 * e]; vv[2 * e + 1] = (bfhi(wv[e]) - mean) * rstd * gq[2 * e + 1] + bq[2 * e + 1]; }
                if (vout) { *(f32x4*)(vout + 8 * i) = (f32x4){vv[0], vv[1], vv[2], vv[3]}; *(f32x4*)(vout + 8 * i + 4) = (f32x4){vv[4], vv[5], vv[6], vv[7]}; }
#pragma unroll
                for (int e = 0; e < 8; ++e) { const int c = part * 128 + 8 * i + e; *(LAS unsigned short*)(lds + c * VP + tk * 2) = (unsigned short)(cvt_pk_bf16(vv[e], 0.f) & 0xffffu); }
            }
        }
    }
    __syncthreads();
    { const int h = wave, half = lane >> 5, x = lane & 31;
        const float* W = a.in[23] + (size_t)h * 128 * 128; const float* BS = a.in[24] + h * 128;
        const int nit = ntok == 128 ? 4 : 1;
        for (int itile = 0; itile < nit; ++itile) {
            const int nks = ntok == 128 ? (itile < 2 ? 4 : 8) : 2;
            const int i = 32 * itile + x;
            f32x16 acc[2];
#pragma unroll
            for (int r = 0; r < 16; ++r) { acc[0][r] = 0.f; acc[1][r] = 0.f; }
            for (int ks = 0; ks < nks; ++ks) {
                const float* wp = W + (size_t)i * 128 + 16 * ks + 8 * half;
                const f32x4 w0 = *(const f32x4*)wp, w1 = *(const f32x4*)(wp + 4);
                v4u wb; wb.x = cvt_pk_bf16(w0.x, w0.y); wb.y = cvt_pk_bf16(w0.z, w0.w); wb.z = cvt_pk_bf16(w1.x, w1.y); wb.w = cvt_pk_bf16(w1.z, w1.w);
                const bf16x8 bfrag = __builtin_bit_cast(bf16x8, wb);
#pragma unroll
                for (int ct = 0; ct < 2; ++ct) { const bf16x8 af = *(const LAS bf16x8*)(lds + (h * 64 + 32 * ct + x) * VP + (16 * ks + 8 * half) * 2); acc[ct] = MFMA32(af, bfrag, acc[ct]); }
            }
            const float bsv = BS[i];
#pragma unroll
            for (int ct = 0; ct < 2; ++ct)
#pragma unroll
                for (int rq = 0; rq < 4; ++rq) { const int c0 = h * 64 + 32 * ct + 8 * rq + 4 * half;
                    const v2u uu = *(const v2u*)(UG + (size_t)(m0 + i) * 512 + c0);
                    const float o0 = bflo(uu.x) * (acc[ct][4 * rq + 0] + bsv), o1 = bfhi(uu.x) * (acc[ct][4 * rq + 1] + bsv), o2 = bflo(uu.y) * (acc[ct][4 * rq + 2] + bsv), o3 = bfhi(uu.y) * (acc[ct][4 * rq + 3] + bsv);
                    v2u w; w.x = cvt_pk_bf16(o0, o1); w.y = cvt_pk_bf16(o2, o3);
                    *(v2u*)(CAT + (size_t)(m0 + i) * 1024 + 512 + c0) = w; }
        }
    }
    __syncthreads();
}

__global__ void __launch_bounds__(512, 2) mega(Args a) {
    extern __shared__ __attribute__((aligned(16))) unsigned char lds_raw[];
    LAS unsigned char* lds = (LAS unsigned char*)lds_raw;
    cg::grid_group grid = cg::this_grid();
    const int tid = threadIdx.x, lane = tid & 63, wave = __builtin_amdgcn_readfirstlane(tid >> 6);
    const int G = gridDim.x, bx = blockIdx.x;
    const int vw = wave * G + bx, NGW = G * 8;
    const int lo = a.ph_lo, hi = a.ph_hi;
    volatile LAS unsigned* xst = (volatile LAS unsigned*)(lds + LDS_BYTES - 64);
    if (tid < 16) xst[tid] = 0u;
    __syncthreads();
    const XcdBarrier xbar = xcd_barrier_post((unsigned*)a.ws, xst);
    if (hi > 1000) grid.sync();
#ifndef REPMASK
#define REPMASK 0
#endif
#ifndef PHMASK
#define PHMASK 0xfff
#endif
#define IN(k) ((((PHMASK) >> (k)) & 1) && lo <= (k) && (k) < hi)
#define SEAM(k) do { if (IN(k) && IN((k) + 1)) xcd_barrier(xbar); } while (0)

    if (IN(0)) for (int rep = 0; rep <= ((REPMASK >> 0) & 1); ++rep) { if (rep) xcd_barrier(xbar); p0_prologue(a, lds, vw, NGW, wave, lane); }
    SEAM(0);
    if (IN(1)) for (int rep = 0; rep <= ((REPMASK >> 1) & 1); ++rep) { if (rep) xcd_barrier(xbar);
        float* modf = (float*)(a.ws + WS_MODF); const float* modp = (const float*)(a.ws + WS_MODP);
        for (int i = bx * 512 + tid; i < 9 * NMOD; i += G * 512) { float s = a.in[9][i % NMOD];
#pragma unroll
            for (int ks = 0; ks < NKS; ++ks) s += modp[(size_t)ks * 9 * NMOD + i];
            modf[i] = s; }
        hprep<0>(a, vw, NGW, lane);
    }
    SEAM(1);
    if (IN(2)) for (int rep = 0; rep <= ((REPMASK >> 2) & 1); ++rep) { if (rep) xcd_barrier(xbar);
        pg8::Gemm g{(const bf16*)(a.ws + WS_H), (const bf16*)(a.ws + WS_WIN), M, INW, D}; pg8::StaticOrder S; S.init(M, INW, G, bx);
        EpiIn E{(bf16*)(a.ws + WS_ZS5), (bf16*)(a.ws + WS_UG), (bf16*)(a.ws + WS_GV)};
        pg8::gemm_phase<EpiIn, pg8::StaticOrder, true, true>(lds, g, S, E);
    }
    SEAM(2);
    if (IN(3)) for (int rep = 0; rep <= ((REPMASK >> 3) & 1); ++rep) { if (rep) xcd_barrier(xbar);
        s5_phase<false>(a, lds + wave * 8704, vw, NGW, lane, 512 * 32);
    }
    SEAM(3);
    if (IN(4)) for (int rep = 0; rep <= ((REPMASK >> 4) & 1); ++rep) { if (rep) xcd_barrier(xbar);
        for (int g = bx; g < 32; g += G) s5_chunk_scan(a, g, lds, tid);
        for (int it = (bx + G - 32) % G; it < 136; it += G) gmlp_item(a, it, lds, tid);
    }
    SEAM(4);
    if (IN(5)) for (int rep = 0; rep <= ((REPMASK >> 5) & 1); ++rep) { if (rep) xcd_barrier(xbar);
        s5_phase<true>(a, lds + wave * 8704, vw, NGW, lane, NCH * 32);
    }
    SEAM(5);
    if (IN(6)) for (int rep = 0; rep <= ((REPMASK >> 6) & 1); ++rep) { if (rep) xcd_barrier(xbar);
        pg8::Gemm g{(const bf16*)(a.ws + WS_YS), (const bf16*)(a.ws + WS_WGLU), M, 512, 512}; pg8::StaticOrder S; S.init(M, 512, G, bx);
        EpiGlu E{(const bf16*)(a.ws + WS_YS), (bf16*)(a.ws + WS_CAT), a.in[20]};
        pg8::gemm_phase<EpiGlu, pg8::StaticOrder, true, true>(lds, g, S, E);
    }
    SEAM(6);
    if (IN(7)) for (int rep = 0; rep <= ((REPMASK >> 7) & 1); ++rep) { if (rep) xcd_barrier(xbar);
        pg8::Gemm g{(const bf16*)(a.ws + WS_CAT), (const bf16*)(a.ws + WS_WOUT), M, D, D}; pg8::StaticOrder S; S.init(M, D, G, bx);
        EpiRes E{a.in[0], a.in[1], (const float*)(a.ws + WS_MODF) + 2 * D, (float*)(a.ws + WS_X1)};
        pg8::gemm_phase<EpiRes, pg8::StaticOrder, true, true>(lds, g, S, E);
    }
    SEAM(7);
    if (IN(8)) for (int rep = 0; rep <= ((REPMASK >> 8) & 1); ++rep) { if (rep) xcd_barrier(xbar); hprep<1>(a, vw, NGW, lane); }
    SEAM(8);
    if (IN(9)) for (int rep = 0; rep <= ((REPMASK >> 9) & 1); ++rep) { if (rep) xcd_barrier(xbar);
        pg8::Gemm g{(const bf16*)(a.ws + WS_H), (const bf16*)(a.ws + WS_WGU), M, GUW, D}; pg8::StaticOrder S; S.init(M, GUW, G, bx);
        EpiGU E{(bf16*)(a.ws + WS_HID)};
        pg8::gemm_phase<EpiGU, pg8::StaticOrder, true, true>(lds, g, S, E);
    }
    SEAM(9);
    if (IN(10)) for (int rep = 0; rep <= ((REPMASK >> 10) & 1); ++rep) { if (rep) xcd_barrier(xbar);
        pg8::Gemm g{(const bf16*)(a.ws + WS_HID), (const bf16*)(a.ws + WS_WD), M, D, DFF}; pg8::StaticOrder S; S.init(M, D, G, bx);
        const float* x1 = (const float*)(a.ws + WS_X1);
        EpiRes E{x1, x1 + (size_t)SEQ * D, (const float*)(a.ws + WS_MODF) + 5 * D, a.out};
        pg8::gemm_phase<EpiRes, pg8::StaticOrder, true, true>(lds, g, S, E);
    }
    SEAM(10);
    if (IN(11)) for (int rep = 0; rep <= ((REPMASK >> 11) & 1); ++rep) { if (rep) xcd_barrier(xbar);
        const float* fg = a.in[28];
        f32x4 gg[4];
#pragma unroll
        for (int j = 0; j < 4; ++j) gg[j] = *(const f32x4*)(fg + 4 * lane + 256 * j);
        f32x4 vn[4];
        if (vw < M) {
#pragma unroll
            for (int j = 0; j < 4; ++j) vn[j] = *(const f32x4*)(a.out + (size_t)vw * D + 4 * lane + 256 * j); }
        for (int m = vw; m < M; m += NGW) { float* row = a.out + (size_t)m * D;
            f32x4 v[4]; float ss = 0.f;
#pragma unroll
            for (int j = 0; j < 4; ++j) v[j] = vn[j];
            if (m + NGW < M) {
#pragma unroll
                for (int j = 0; j < 4; ++j) vn[j] = *(const f32x4*)(row + (size_t)NGW * D + 4 * lane + 256 * j); }
#pragma unroll
            for (int j = 0; j < 4; ++j) ss += (v[j].x * v[j].x + v[j].y * v[j].y) + (v[j].z * v[j].z + v[j].w * v[j].w);
            const float rstd = 1.0f / sqrtf(wave_sum(ss) * (1.0f / D) + EPS);
#pragma unroll
            for (int j = 0; j < 4; ++j) *(f32x4*)(row + 4 * lane + 256 * j) = v[j] * rstd * gg[j]; }
    }
#undef IN
#undef SEAM
}

#ifndef MK_PER_PHASE
#define MK_PER_PHASE 0
#endif
extern "C" void kernel_launch(void* const* d_in, const int* in_sizes, int n_in, void* d_out, int out_size, void* d_ws, size_t ws_size, hipStream_t stream) {
    static int grid = 0;
    if (grid == 0) {
        int dev = 0, cus = 0, per_cu = 0;
        if (n_in != 29 || ws_size < WS_END) { fprintf(stderr, "kernel_launch: unexpected n_in %d / ws %zu\n", n_in, ws_size); grid = -1; return; }
        hipGetDevice(&dev); hipDeviceGetAttribute(&cus, hipDeviceAttributeMultiprocessorCount, dev);
        hipFuncSetAttribute((const void*)mega, hipFuncAttributeMaxDynamicSharedMemorySize, LDS_BYTES);
        hipOccupancyMaxActiveBlocksPerMultiprocessor(&per_cu, (const void*)mega, 512, LDS_BYTES);
        if (per_cu < 1) { fprintf(stderr, "kernel_launch: occupancy query says %d blocks/CU\n", per_cu); per_cu = 1; }
        (void)hipGetLastError();
        grid = cus * 1;
    }
    if (grid < 0) return;
    Args a{};
    for (int i = 0; i < 29; ++i) a.in[i] = (const float*)d_in[i];
    a.out = (float*)d_out; a.ws = (unsigned char*)d_ws;
    a.ph_lo = 0; a.ph_hi = NPH;
    if (hipMemsetAsync(d_ws, 0, 16384, stream) != hipSuccess) { fprintf(stderr, "kernel_launch: memset of the barrier words failed\n"); return; }
    void* args[] = {&a};
    hipError_t e = hipLaunchCooperativeKernel((const void*)mega, dim3(grid), dim3(512), args, LDS_BYTES, stream);
    if (e != hipSuccess) fprintf(stderr, "cooperative launch failed: %s (grid %d)\n", hipGetErrorString(e), grid);
}
```

```cpp
#include <hip/hip_runtime.h>
#include <hip/hip_cooperative_groups.h>
#include <cstdio>
#include <cstdint>
namespace cg = cooperative_groups;
namespace pg8 {
#define PG8_LAS __attribute__((address_space(3)))
typedef unsigned short bf16_t;
typedef short bf16x8 __attribute__((ext_vector_type(8)));
typedef float f32x4 __attribute__((ext_vector_type(4)));
typedef unsigned u32x4 __attribute__((ext_vector_type(4)));
constexpr int BM = 256, BK = 64, HALF = 128, HTB = HALF * BK * 2  , STAGE_BYTES = 8 * HTB, NXCD = 8, WGM = 8;

__host__ __device__ __forceinline__ int lds_byte(int r, int c) { const int st = (r >> 4) * 2 + (c >> 5), rr = r & 15, cc = c & 31, ob = rr * 64 + cc * 2; return st * 1024 + (ob ^ (((ob >> 9) & 1) << 5)); }
__host__ __device__ __forceinline__ void stage_rc(int b, int& R, int& C) { const int st = b / 1024, sb = b % 1024, swz = sb ^ (((sb >> 9) & 1) << 5); R = (st >> 1) * 16 + swz / 64; C = (st & 1) * 32 + (swz % 64) / 2; }
__host__ __device__ __forceinline__ int perm32(int rho) { const int n = rho >> 4, i = rho & 15; return 8 * (i >> 2) + 4 * n + (i & 3); }

struct Unit { int pm, pn; };
struct Gemm { const bf16_t* A; const bf16_t* Bt; int M, N, K; };

struct StaticOrder {
    int nM, nN, nwg, G, c;
    __host__ __device__ void init(int M, int N, int G_, int c_) { nM = M / BM; nN = N / BM; nwg = nM * nN; G = G_; c = c_; }
    __host__ __device__ bool next(int i, Unit& u) const {
        const long L = (long)i * G + c; if (L >= nwg) return false;
        int wgid = (int)L; { const int q = nwg / NXCD, r = nwg % NXCD, xcd = wgid % NXCD, off = wgid / NXCD; wgid = (xcd < r ? xcd * (q + 1) : r * (q + 1) + (xcd - r) * q) + off; }
        const int nig = WGM * nN, gid = wgid / nig, fm = gid * WGM, gsz = (nM - fm) < WGM ? (nM - fm) : WGM;
        u.pm = fm + ((wgid % nig) % gsz); u.pn = (wgid % nig) / gsz; return true;
    }
    __device__ __forceinline__ void a_ready(const Unit&) const {}
    __device__ __forceinline__ void done(const Unit&) const {}
};
__device__ __forceinline__ unsigned cvt_pk_bf16(float lo, float hi) { unsigned r; asm volatile("v_cvt_pk_bf16_f32 %0, %1, %2" : "=v"(r) : "v"(lo), "v"(hi)); return r; }
template <class Epi, class Sched, bool ALIGN_EPI = false, bool SP2 = false>
__device__ __forceinline__ void gemm_phase(PG8_LAS unsigned char* lds, const Gemm g, const Sched& S, const Epi& E) {
    const int tid = threadIdx.x, wid = __builtin_amdgcn_readfirstlane(tid >> 6), lane = tid & 63, wr = wid >> 2, wc = wid & 3, fr = lane & 15, fq = lane >> 4;
    const int K = g.K, nt = K / BK;
    unsigned voffA[2], voffB[2];
#pragma unroll
    for (int i = 0; i < 2; ++i) { int R, C; stage_rc(tid * 16 + i * 8192, R, C); const int Rb = Epi::PERM ? ((R & ~31) + perm32(R & 31)) : R;
        voffA[i] = (unsigned)(R * K + C) * 2u; voffB[i] = (unsigned)(Rb * K + C) * 2u; }
    const size_t kstep = (size_t)(BK * 2);
    const size_t hstep = (size_t)HALF * K * 2;
    const size_t tstep = 2 * hstep;
    const unsigned ldsw = (unsigned)wid * 1024u;
    const int aoff = lds_byte(wr * 64 + fr, fq * 8), boff = lds_byte(wc * 32 + fr, fq * 8);
#define PG8_SA(b, h) (((b) * 2 + (h)) * HTB)
#define PG8_SB(b, h) ((4 + (b) * 2 + (h)) * HTB)
#define PG8_STAGE(bufoff, gbase, voff) do { _Pragma("unroll") for (int _i = 0; _i < 2; ++_i) \
        __builtin_amdgcn_global_load_lds((const unsigned*)((const char*)(gbase) + (voff)[_i]), (PG8_LAS unsigned*)(lds + (bufoff) + ldsw + _i * 8192), 16, 0, 0); } while (0)
#define PG8_LDA(dst, b, h) do { _Pragma("unroll") for (int m = 0; m < 4; ++m) _Pragma("unroll") for (int k = 0; k < 2; ++k) dst[m][k] = *(const PG8_LAS bf16x8*)(lds + PG8_SA(b, h) + aoff + m * 2048 + k * 1024); } while (0)
#define PG8_LDB(dst, b, h) do { _Pragma("unroll") for (int n = 0; n < 2; ++n) _Pragma("unroll") for (int k = 0; k < 2; ++k) dst[n][k] = *(const PG8_LAS bf16x8*)(lds + PG8_SB(b, h) + boff + n * 2048 + k * 1024); } while (0)
#define PG8_MMA(ai, bj, At, Bt) do { __builtin_amdgcn_s_setprio(1); _Pragma("unroll") for (int m = 0; m < 4; ++m) _Pragma("unroll") for (int n = 0; n < 2; ++n) _Pragma("unroll") for (int k = 0; k < 2; ++k) \
        acc[ai][bj][m][n] = __builtin_amdgcn_mfma_f32_16x16x32_bf16(Bt[n][k], At[m][k], acc[ai][bj][m][n], 0, 0, 0); __builtin_amdgcn_s_setprio(0); } while (0)
#define PG8_WAIT_V(n) asm volatile("s_waitcnt vmcnt(" #n ")" ::: "memory")
#define PG8_WAIT_L(n) asm volatile("s_waitcnt lgkmcnt(" #n ")" ::: "memory")
#define PG8_BAR __builtin_amdgcn_s_barrier()
#define PG8_SCHED __builtin_amdgcn_sched_barrier(0)
    Unit cur, nxt; int ui = 0;
    if (!S.next(0, cur)) return;
    f32x4 acc[2][2][4][2];
#pragma unroll
    for (int a = 0; a < 2; ++a)
#pragma unroll
        for (int b = 0; b < 2; ++b)
#pragma unroll
            for (int m = 0; m < 4; ++m)
#pragma unroll
                for (int n = 0; n < 2; ++n) acc[a][b][m][n] = (f32x4){0.f, 0.f, 0.f, 0.f};
    bf16x8 At[4][2], B0[2][2], B1[2][2];
    const char* cA = (const char*)g.A + (size_t)cur.pm * tstep; const char* cB = (const char*)g.Bt + (size_t)cur.pn * tstep;
    S.a_ready(cur);
    if constexpr (SP2) {
        PG8_STAGE(PG8_SB(0, 0), cB, voffB); PG8_STAGE(PG8_SB(0, 1), cB + hstep, voffB); PG8_STAGE(PG8_SA(0, 0), cA, voffA); PG8_STAGE(PG8_SA(0, 1), cA + hstep, voffA);
        if (wr == 1) PG8_BAR;
        PG8_WAIT_V(2); PG8_BAR;
        PG8_STAGE(PG8_SB(1, 0), cB + kstep, voffB); PG8_STAGE(PG8_SA(1, 0), cA + kstep, voffA); PG8_STAGE(PG8_SB(1, 1), cB + hstep + kstep, voffB);
        PG8_WAIT_V(6); PG8_BAR;
    } else {
        PG8_STAGE(PG8_SB(0, 0), cB, voffB); PG8_STAGE(PG8_SA(0, 0), cA, voffA); PG8_STAGE(PG8_SB(0, 1), cB + hstep, voffB); PG8_STAGE(PG8_SA(0, 1), cA + hstep, voffA);
        if (wr == 1) PG8_BAR;
        PG8_WAIT_V(4); PG8_BAR;
        PG8_STAGE(PG8_SB(1, 0), cB + kstep, voffB); PG8_STAGE(PG8_SA(1, 0), cA + kstep, voffA); PG8_STAGE(PG8_SB(1, 1), cB + hstep + kstep, voffB);
        PG8_WAIT_V(6); PG8_BAR;
    }
    for (;;) {
        const bool has_next = S.next(ui + 1, nxt);
        const char* nA = has_next ? (const char*)g.A + (size_t)nxt.pm * tstep : cA; const char* nB = has_next ? (const char*)g.Bt + (size_t)nxt.pn * tstep : cB;
        for (int t = 0; t < nt; t += 2) {
            const bool last = (t == nt - 2);
            const char* a1 = cA + (size_t)(t + 1) * kstep;
            const char* a2 = last ? nA : cA + (size_t)(t + 2) * kstep; const char* b2 = last ? nB : cB + (size_t)(t + 2) * kstep;
            const char* a3 = a2 + kstep; const char* b3 = b2 + kstep;
            if (last && has_next) S.a_ready(nxt);
            if constexpr (SP2) {
            PG8_LDB(B0, 0, 0); PG8_LDB(B1, 0, 1); PG8_SCHED; PG8_LDA(At, 0, 0); PG8_STAGE(PG8_SA(1, 1), a1 + hstep, voffA);
            PG8_WAIT_V(8); PG8_WAIT_L(0); PG8_BAR; PG8_MMA(0, 0, At, B0); PG8_MMA(0, 1, At, B1); PG8_BAR; PG8_SCHED;
            PG8_LDA(At, 0, 1); PG8_STAGE(PG8_SB(0, 0), b2, voffB); PG8_STAGE(PG8_SB(0, 1), b2 + hstep, voffB); PG8_STAGE(PG8_SA(0, 0), a2, voffA);
            PG8_WAIT_V(8); PG8_WAIT_L(0); PG8_BAR; PG8_MMA(1, 0, At, B0); PG8_MMA(1, 1, At, B1); PG8_BAR; PG8_SCHED;
            PG8_LDB(B0, 1, 0); PG8_LDB(B1, 1, 1); PG8_SCHED; PG8_LDA(At, 1, 0); PG8_STAGE(PG8_SA(0, 1), a2 + hstep, voffA);
            PG8_WAIT_V(8); PG8_WAIT_L(0); PG8_BAR; PG8_MMA(0, 0, At, B0); PG8_MMA(0, 1, At, B1); PG8_BAR; PG8_SCHED;
            PG8_LDA(At, 1, 1); PG8_STAGE(PG8_SB(1, 0), b3, voffB); PG8_STAGE(PG8_SB(1, 1), b3 + hstep, voffB); PG8_STAGE(PG8_SA(1, 0), a3, voffA);
            PG8_WAIT_V(8); PG8_WAIT_L(0); PG8_BAR; PG8_MMA(1, 0, At, B0); PG8_MMA(1, 1, At, B1); PG8_BAR; PG8_SCHED;
            } else {
            PG8_LDB(B0, 0, 0); PG8_SCHED; PG8_LDA(At, 0, 0); PG8_STAGE(PG8_SA(1, 1), a1 + hstep, voffA);
            PG8_WAIT_L(8); PG8_BAR; PG8_WAIT_L(0); PG8_MMA(0, 0, At, B0); PG8_BAR; PG8_SCHED;
            PG8_LDB(B1, 0, 1); PG8_STAGE(PG8_SB(0, 0), b2, voffB);
            PG8_BAR; PG8_WAIT_L(0); PG8_MMA(0, 1, At, B1); PG8_BAR;
            PG8_LDA(At, 0, 1); PG8_STAGE(PG8_SA(0, 0), a2, voffA);
            PG8_BAR; PG8_WAIT_L(0); PG8_MMA(1, 0, At, B0); PG8_BAR; PG8_SCHED;
            PG8_STAGE(PG8_SB(0, 1), b2 + hstep, voffB);
            PG8_WAIT_V(6); PG8_BAR; PG8_MMA(1, 1, At, B1); PG8_BAR;
            PG8_LDB(B0, 1, 0); PG8_SCHED; PG8_LDA(At, 1, 0); PG8_STAGE(PG8_SA(0, 1), a2 + hstep, voffA);
            PG8_WAIT_L(8); PG8_BAR; PG8_WAIT_L(0); PG8_MMA(0, 0, At, B0); PG8_BAR; PG8_SCHED;
            PG8_LDB(B1, 1, 1); PG8_STAGE(PG8_SB(1, 0), b3, voffB);
            PG8_BAR; PG8_WAIT_L(0); PG8_MMA(0, 1, At, B1); PG8_BAR;
            PG8_LDA(At, 1, 1); PG8_STAGE(PG8_SA(1, 0), a3, voffA);
            PG8_BAR; PG8_WAIT_L(0); PG8_MMA(1, 0, At, B0); PG8_BAR; PG8_SCHED;
            PG8_STAGE(PG8_SB(1, 1), b3 + hstep, voffB);
            PG8_WAIT_V(6); PG8_BAR; PG8_MMA(1, 1, At, B1); PG8_BAR;
            }
        }
        if constexpr (ALIGN_EPI) { if (wr == 0) PG8_BAR; }
        if constexpr (!Epi::AFTER_DRAIN) { E(acc, cur, wr, wc, fr, fq); S.done(cur); }
        if (!has_next) break;
#pragma unroll
        for (int a = 0; a < 2; ++a)
#pragma unroll
            for (int b = 0; b < 2; ++b)
#pragma unroll
                for (int m = 0; m < 4; ++m)
#pragma unroll
                    for (int n = 0; n < 2; ++n) acc[a][b][m][n] = (f32x4){0.f, 0.f, 0.f, 0.f};
        cur = nxt; cA = nA; cB = nB; ++ui;
        if constexpr (ALIGN_EPI) { if (wr == 1) PG8_BAR; }
    }
    PG8_WAIT_V(0);
    if constexpr (!ALIGN_EPI) { if (wr == 0) PG8_BAR; }
    PG8_BAR;
    if constexpr (Epi::AFTER_DRAIN) { E.fused(acc, cur, wr, wc, fr, fq, lds, wid, lane); S.done(cur); }
#undef PG8_SA
#undef PG8_SB
#undef PG8_STAGE
#undef PG8_LDA
#undef PG8_LDB
#undef PG8_MMA
#undef PG8_WAIT_V
#undef PG8_WAIT_L
#undef PG8_BAR
#undef PG8_SCHED
}
}

#define GAS __attribute__((address_space(1)))
#define LAS __attribute__((address_space(3)))
typedef unsigned short bf16;
typedef unsigned v4u __attribute__((ext_vector_type(4)));
typedef unsigned v2u __attribute__((ext_vector_type(2)));
typedef float f32x4 __attribute__((ext_vector_type(4)));
typedef float f32x2 __attribute__((ext_vector_type(2)));
typedef float f32x16 __attribute__((ext_vector_type(16)));
typedef short bf16x8 __attribute__((ext_vector_type(8)));
using pg8::cvt_pk_bf16;

constexpr int D = 1024, SEQ = 16384, NSB = 8, NST = 32, M = SEQ + NSB * NST  , INW = 1536, DFF = 2816, GUW = 2 * DFF, NMOD = 6 * D;
constexpr int NCH = M / 32;
constexpr float EPS = 1e-6f;
constexpr size_t O_PRE = (size_t)M * D, O_PIM = O_PRE + 2048, O_SRE = O_PIM + 2048, O_SIM = O_SRE + 16384, O_V = O_SIM + 16384;

constexpr size_t MiB = 1u << 20, KiB = 1u << 10;
constexpr size_t WS_MODP = 240 * MiB;
constexpr int NKS = 16;
constexpr size_t WS_MODF = 2 * MiB;
constexpr size_t WS_TB = 2 * MiB + 512 * KiB;
constexpr size_t WS_TC = WS_TB + 128 * KiB;
constexpr size_t WS_TA = WS_TC + 128 * KiB;
constexpr size_t WS_TP = WS_TA + 64 * KiB;
constexpr size_t WS_STATS = 3 * MiB;
constexpr size_t WS_WIN = 4 * MiB, WS_WGLU = 7 * MiB, WS_WOUT = 8 * MiB, WS_WGU = 10 * MiB, WS_WD = 21 * MiB;
constexpr size_t WS_SLOC = 27 * MiB, WS_SST = 35 * MiB;
constexpr size_t WS_H = 44 * MiB;
constexpr size_t WS_X1 = 77 * MiB;
constexpr size_t ACT5 = (size_t)M * 512 * 2;
constexpr size_t WS_ZS5 = 142 * MiB, WS_UG = WS_ZS5 + ACT5, WS_GV = WS_UG + ACT5, WS_YS = WS_GV + ACT5, WS_CAT = WS_YS + ACT5;
constexpr size_t WS_HID = 142 * MiB;
constexpr size_t WS_END = WS_CAT + (size_t)M * 1024 * 2;
static_assert(WS_END <= 256 * MiB && WS_HID + (size_t)M * DFF * 2 <= WS_END, "ws map");
constexpr int LDS_BYTES = 147456;
constexpr int NPH = 12;

__device__ __forceinline__ float bf2f(unsigned short b) { return __builtin_bit_cast(float, ((unsigned)b) << 16); }
__device__ __forceinline__ float bflo(unsigned w) { return __builtin_bit_cast(float, w << 16); }
__device__ __forceinline__ float bfhi(unsigned w) { return __builtin_bit_cast(float, w & 0xffff0000u); }
__device__ __forceinline__ float sigm(float x) { return __builtin_amdgcn_rcpf(1.f + __expf(-x)); }
__device__ __forceinline__ float gelu_t(float x) { const float z = 1.5957691216f * (x + 0.044715f * x * x * x); return x * sigm(z); }
__device__ __forceinline__ float silu_f(float x) { return x * sigm(x); }
__device__ __forceinline__ float wave_sum(float v) {
#pragma unroll
    for (int o = 1; o < 64; o <<= 1) v += __shfl_xor(v, o);
    return v;
}
#define LDS_WAIT() asm volatile("s_waitcnt lgkmcnt(0)" ::: "memory")

#define XB_TMO      128
#define XB_XCNT(j)  (256  + 64 * (j))
#define XB_XSUB(j)  (1280 + 64 * (j))
#define XB_XGEN(j)  (2304 + 64 * (j))
#define XB_TOP      3328
#define XB_TOPGEN   3392
#define XCD_BAR_WORDS 3456
#define XB_SPIN_CAP (1u << 18)

__device__ __forceinline__ unsigned xb_ld(unsigned* p)              { return __hip_atomic_load(p, __ATOMIC_RELAXED, __HIP_MEMORY_SCOPE_AGENT); }
__device__ __forceinline__ unsigned xb_add(unsigned* p, unsigned v) { return __hip_atomic_fetch_add(p, v, __ATOMIC_RELAXED, __HIP_MEMORY_SCOPE_AGENT); }
__device__ __forceinline__ unsigned xb_xcc_id() { return (unsigned)__builtin_amdgcn_s_getreg((3 << 11) | 20) & 0xFu; }
#define XB_SPIN(cond, bar) do { unsigned _sp = 0; while (cond) { __builtin_amdgcn_s_sleep(1); \
    if ((++_sp & 255u) == 0u) { if (xb_ld(&(bar)[XB_TMO])) break; if (_sp > XB_SPIN_CAP) { atomicAdd(&(bar)[XB_TMO], 1u); break; } } } } while (0)

struct XcdBarrier {
    unsigned* bar; unsigned x;
    volatile LAS unsigned* st;
};

__device__ __forceinline__ XcdBarrier xcd_barrier_post(unsigned* bar, volatile LAS unsigned* st) {
    XcdBarrier b; b.bar = bar; b.x = xb_xcc_id(); b.st = st;
    if (threadIdx.x == 0) (void)xb_add(&bar[XB_XCNT(b.x)], 1u);
    return b;
}
__device__ __forceinline__ void xcd_barrier_complete(unsigned* bar, unsigned x, unsigned& nloc, unsigned& nx) {
    const unsigned G = gridDim.x * gridDim.y * gridDim.z;
    unsigned sum, cnt, mine, sp = 0u;
    for (;;) {
        sum = 0u; cnt = 0u; mine = 0u;
#pragma unroll
        for (unsigned j = 0; j < 16; ++j) { const unsigned c = xb_ld(&bar[XB_XCNT(j)]); sum += c; cnt += (c > 0u) ? 1u : 0u; mine = (j == x) ? c : mine; }
        if (sum == G) break;
        __builtin_amdgcn_s_sleep(1);
        if ((++sp & 255u) == 0u) { if (xb_ld(&bar[XB_TMO])) break; if (sp > XB_SPIN_CAP) { atomicAdd(&bar[XB_TMO], 1u); break; } }
    }
    nloc = mine > 0u ? mine : 1u; nx = cnt > 0u ? cnt : 1u;
}

__device__ __forceinline__ void xcd_barrier(const XcdBarrier& b) {
    asm volatile("s_waitcnt vmcnt(0)" ::: "memory");
    __syncthreads();
    if (threadIdx.x == 0) {
        unsigned* bar = b.bar;
        __builtin_amdgcn_s_waitcnt(0);
        unsigned nloc = b.st[0], nx = b.st[1];
        if (nloc == 0u) { xcd_barrier_complete(bar, b.x, nloc, nx); b.st[0] = nloc; b.st[1] = nx; }
        const unsigned old = xb_add(&bar[XB_XSUB(b.x)], 1u);
        const unsigned gen = old / nloc;
        if (old + 1u == (gen + 1u) * nloc) {
            __builtin_amdgcn_fence(__ATOMIC_RELEASE, "agent");
            asm volatile("s_waitcnt vmcnt(0)" ::: "memory");
            const unsigned og = xb_add(&bar[XB_TOP], 1u);
            const unsigned tg = og / nx;
            if (og + 1u == (tg + 1u) * nx) xb_add(&bar[XB_TOPGEN], 1u);
            else XB_SPIN(xb_ld(&bar[XB_TOPGEN]) == tg, bar);
            __builtin_amdgcn_fence(__ATOMIC_ACQUIRE, "agent");
            xb_add(&bar[XB_XGEN(b.x)], 1u);
            asm volatile("s_waitcnt vmcnt(0)" ::: "memory");
        } else {
            XB_SPIN(xb_ld(&bar[XB_XGEN(b.x)]) == gen, bar);
            __builtin_amdgcn_fence(__ATOMIC_ACQUIRE, "agent");
            asm volatile("s_waitcnt vmcnt(0)" ::: "memory");
        }
    }
    __syncthreads();
}

struct Args { const float* in[29]; float* out; unsigned char* ws; int ph_lo, ph_hi; };

__device__ __forceinline__ void p0_transpose_item(const float* W, int K, int N, bf16* WT, int dst_row0, LAS float* scr, int kb, int nb, int lane) {
    const int k0 = 64 * kb, n0 = 32 * nb;
#pragma unroll
    for (int i = 0; i < 32; ++i) { const int kk = 2 * i + (lane >> 5); scr[kk * 33 + (lane & 31)] = W[(size_t)(k0 + kk) * N + n0 + (lane & 31)]; }
    LDS_WAIT();
    const int c = lane & 7;
#pragma unroll
    for (int j = 0; j < 4; ++j) { const int n = (lane >> 3) + 8 * j; const LAS float* s = scr + (8 * c) * 33 + n;
        v4u o; o.x = cvt_pk_bf16(s[0 * 33], s[1 * 33]); o.y = cvt_pk_bf16(s[2 * 33], s[3 * 33]); o.z = cvt_pk_bf16(s[4 * 33], s[5 * 33]); o.w = cvt_pk_bf16(s[6 * 33], s[7 * 33]);
        *(v4u*)(WT + (size_t)(dst_row0 + n) * K + k0 + 8 * c) = o; }
    LDS_WAIT();
}
__device__ __forceinline__ float rl(float v, int l) { return __builtin_bit_cast(float, __builtin_amdgcn_readlane(__builtin_bit_cast(int, v), l)); }

__device__ __forceinline__ void p0_ada_item(const Args& a, int cs, int ks, int lane) {
    const float* cp = a.in[4]; const float* csm = a.in[5]; const float* W = a.in[8];
    float* modp = (float*)(a.ws + WS_MODP);
    const int c0 = cs * 256 + 4 * lane, k0 = ks * 64;
    float sl[9];
#pragma unroll
    for (int b = 0; b < 9; ++b) { const int k = k0 + lane; const float cv = (b == 0) ? cp[k] : csm[(b - 1) * D + k]; sl[b] = silu_f(cv); }
    f32x4 acc[9];
#pragma unroll
    for (int b = 0; b < 9; ++b) acc[b] = (f32x4){0.f, 0.f, 0.f, 0.f};
#pragma unroll 16
    for (int kk = 0; kk < 64; ++kk) {
        const f32x4 w = *(const f32x4*)(W + (size_t)(k0 + kk) * NMOD + c0);
#pragma unroll
        for (int b = 0; b < 9; ++b) { const float s = rl(sl[b], kk); acc[b] += w * s; }
    }
#pragma unroll
    for (int b = 0; b < 9; ++b) *(f32x4*)(modp + ((size_t)ks * 9 + b) * NMOD + c0) = acc[b];
}

__device__ __forceinline__ void p0_s5_tables(const Args& a, int g, int lane) {
    const int n = lane;
    const float step = expf(a.in[13][g]);
    const float lr = a.in[11][g * 64 + n], li = a.in[12][g * 64 + n];
    const float x = lr * step, y = li * step;
    const float ex = expf(x), cy = cosf(y), sy = sinf(y), sh = sinf(0.5f * y);
    const float a1r = ex * cy, a1i = ex * sy;
    const float mr = expm1f(x) * cy - 2.f * sh * sh, mi = ex * sy;
    const float den = lr * lr + li * li;
    const float fr = (mr * lr + mi * li) / den, fi = (mi * lr - mr * li) / den;
    bf16* TB = (bf16*)(a.ws + WS_TB); bf16* TC = (bf16*)(a.ws + WS_TC); float* TA = (float*)(a.ws + WS_TA); float* TP = (float*)(a.ws + WS_TP);
    const float* br = a.in[14] + (size_t)(g * 64 + n) * 16; const float* bi = a.in[15] + (size_t)(g * 64 + n) * 16;
    const int xx = n >> 1, sbit = n & 1;
    bf16* rowre = TB + (size_t)(g * 128 + (0 + sbit) * 32 + xx) * 16;
    bf16* rowim = TB + (size_t)(g * 128 + (2 + sbit) * 32 + xx) * 16;
#pragma unroll
    for (int q = 0; q < 16; q += 2) {
        const float b0r = br[q], b0i = bi[q], b1r = br[q + 1], b1i = bi[q + 1];
        *(unsigned*)(rowre + q) = cvt_pk_bf16(fr * b0r - fi * b0i, fr * b1r - fi * b1i);
        *(unsigned*)(rowim + q) = cvt_pk_bf16(fr * b0i + fi * b0r, fr * b1i + fi * b1r);
    }
    double pr = a1r, pi = a1i;
    double p2r = pr * pr - pi * pi, p2i = 2.0 * pr * pi;
    double p3r = p2r * pr - p2i * pi, p3i = p2r * pi + p2i * pr;
    double p4r = p2r * p2r - p2i * p2i, p4i = 2.0 * p2r * p2i;
    float* ta = TA + (size_t)(g * 64 + n) * 8;
    ta[0] = (float)pr; ta[1] = (float)pi; ta[2] = (float)p2r; ta[3] = (float)p2i; ta[4] = (float)p3r; ta[5] = (float)p3i; ta[6] = (float)p4r; ta[7] = (float)p4i;
    double qr = p4r, qi = p4i;
#pragma unroll
    for (int s = 0; s < 3; ++s) { const double t = qr * qr - qi * qi; qi = 2.0 * qr * qi; qr = t; }
    float* tp = TP + (size_t)(g * 64 + n) * 4;
    tp[0] = (float)qr; tp[1] = (float)qi;
#pragma unroll
    for (int s = 0; s < 6; ++s) { const double t = qr * qr - qi * qi; qi = 2.0 * qr * qi; qr = t; }
    tp[2] = (float)qr; tp[3] = (float)qi;
    const float* cr = a.in[16] + (size_t)g * 16 * 64; const float* ci = a.in[17] + (size_t)g * 16 * 64;
#pragma unroll
    for (int p = 0; p < 16; ++p) { TC[(size_t)(g * 16 + p) * 128 + n] = (bf16)(cvt_pk_bf16(cr[p * 64 + n], 0.f) & 0xffffu); TC[(size_t)(g * 16 + p) * 128 + 64 + n] = (bf16)(cvt_pk_bf16(-ci[p * 64 + n], 0.f) & 0xffffu); }
}

__device__ __forceinline__ void p0_prologue(const Args& a, LAS unsigned char* lds, int vw, int NGW, int wave, int lane) {
    LAS float* scr = (LAS float*)(lds + wave * 16384);
    constexpr int I_ADA = 24 * NKS, I_S5 = 32, I_IN = 16 * 48, I_GLU = 8 * 16, I_OUT = 16 * 32, I_GU = 16 * 176, I_D = 44 * 32;
    constexpr int NITEMS = I_ADA + I_S5 + I_IN + I_GLU + I_OUT + I_GU + I_D;
    for (int it = vw; it < NITEMS; it += NGW) {
        int r = it;
        if (r < I_ADA) { p0_ada_item(a, r % 24, r / 24, lane); continue; } r -= I_ADA;
        if (r < I_S5) { p0_s5_tables(a, r, lane); continue; } r -= I_S5;
        if (r < I_IN) { const int nblk = INW / 32, kb = r / nblk, nb = r % nblk; p0_transpose_item(a.in[10], D, INW, (bf16*)(a.ws + WS_WIN), 32 * nb, scr, kb, nb, lane); continue; } r -= I_IN;
        if (r < I_GLU) { const int nblk = 16, kb = r / nblk, nb = r % nblk; p0_transpose_item(a.in[19], 512, 512, (bf16*)(a.ws + WS_WGLU), 32 * nb, scr, kb, nb, lane); continue; } r -= I_GLU;
        if (r < I_OUT) { const int nblk = 32, kb = r / nblk, nb = r % nblk; p0_transpose_item(a.in[25], D, D, (bf16*)(a.ws + WS_WOUT), 32 * nb, scr, kb, nb, lane); continue; } r -= I_OUT;
        if (r < I_GU) { const int nblk = GUW / 32, kb = r / nblk, nb = r % nblk; const int n0 = 32 * nb; const int j = n0 < DFF ? n0 : n0 - DFF;
            const int drow = 256 * (j >> 7) + (n0 < DFF ? 0 : 128) + (j & 127);
            p0_transpose_item(a.in[26], D, GUW, (bf16*)(a.ws + WS_WGU), drow, scr, kb, nb, lane); continue; } r -= I_GU;
        { const int nblk = 32, kb = r / nblk, nb = r % nblk; p0_transpose_item(a.in[27], DFF, D, (bf16*)(a.ws + WS_WD), 32 * nb, scr, kb, nb, lane); }
    }
}

template <int WHICH>
__device__ __forceinline__ void hprep(const Args& a, int vw, int NGW, int lane) {
    const float* gvec = a.in[WHICH == 0 ? 6 : 7];
    const float* modp = (const float*)(a.ws + WS_MODP); const float* modf = (const float*)(a.ws + WS_MODF); const float* bada = a.in[9];
    bf16* H = (bf16*)(a.ws + WS_H);
    const int soff = WHICH == 0 ? 0 : 3 * D, coff = soff + D;
    int cur = -1; f32x4 ca[4], cb[4], vn[4];
    if (vw < M) { const float* xr0 = WHICH == 0 ? (vw < SEQ ? a.in[0] + (size_t)vw * D : a.in[1] + (size_t)(vw - SEQ) * D) : (const float*)(a.ws + WS_X1) + (size_t)vw * D;
#pragma unroll
        for (int j = 0; j < 4; ++j) vn[j] = *(const f32x4*)(xr0 + 4 * lane + 256 * j); }
    for (int m = vw; m < M; m += NGW) {
        const int mr = m < SEQ ? 0 : 1 + ((m - SEQ) >> 5);
        if (mr != cur) { cur = mr;
#pragma unroll
            for (int j = 0; j < 4; ++j) { const int k = 4 * lane + 256 * j; f32x4 sc, sh;
                if (WHICH == 0) { sc = *(const f32x4*)(bada + coff + k); sh = *(const f32x4*)(bada + soff + k);
#pragma unroll
                    for (int ks = 0; ks < NKS; ++ks) { sc += *(const f32x4*)(modp + ((size_t)ks * 9 + mr) * NMOD + coff + k); sh += *(const f32x4*)(modp + ((size_t)ks * 9 + mr) * NMOD + soff + k); } }
                else { sc = *(const f32x4*)(modf + (size_t)mr * NMOD + coff + k); sh = *(const f32x4*)(modf + (size_t)mr * NMOD + soff + k); }
                const f32x4 gg = *(const f32x4*)(gvec + k); ca[j] = gg * (sc + 1.0f); cb[j] = sh; } }
        f32x4 v[4]; float ss = 0.f;
#pragma unroll
        for (int j = 0; j < 4; ++j) v[j] = vn[j];
        { const int m2 = m + NGW; if (m2 < M) { const float* xr2 = WHICH == 0 ? (m2 < SEQ ? a.in[0] + (size_t)m2 * D : a.in[1] + (size_t)(m2 - SEQ) * D) : (const float*)(a.ws + WS_X1) + (size_t)m2 * D;
#pragma unroll
            for (int j = 0; j < 4; ++j) vn[j] = *(const f32x4*)(xr2 + 4 * lane + 256 * j); } }
#pragma unroll
        for (int j = 0; j < 4; ++j) ss += (v[j].x * v[j].x + v[j].y * v[j].y) + (v[j].z * v[j].z + v[j].w * v[j].w);
        const float rstd = 1.0f / sqrtf(wave_sum(ss) * (1.0f / D) + EPS);
#pragma unroll
        for (int j = 0; j < 4; ++j) { const f32x4 o = v[j] * rstd * ca[j] + cb[j]; v2u w; w.x = cvt_pk_bf16(o.x, o.y); w.y = cvt_pk_bf16(o.z, o.w);
            *(v2u*)(H + (size_t)m * D + 4 * lane + 256 * j) = w; }
    }
}

using pg8::Unit;
struct EpiIn {
    static constexpr bool PERM = true, AFTER_DRAIN = false;
    bf16 *zs5, *ug, *gv;
    __device__ __forceinline__ void operator()(const f32x4 (&acc)[2][2][4][2], const Unit& u, int wr, int wc, int fr, int fq) const {
        const int sec = u.pn >> 1; bf16* base = zs5 + (size_t)sec * (ACT5 / 2);
        const int row0 = u.pm * 256 + wr * 64 + fr, col0 = (u.pn & 1) * 256 + wc * 32 + 8 * fq;
#pragma unroll
        for (int ai = 0; ai < 2; ++ai)
#pragma unroll
            for (int m = 0; m < 4; ++m) { bf16* rowp = base + (size_t)(row0 + ai * 128 + m * 16) * 512 + col0;
#pragma unroll
                for (int bj = 0; bj < 2; ++bj) { const f32x4 v0 = acc[ai][bj][m][0], v1 = acc[ai][bj][m][1];
                    v4u w;
                    if (sec) { w.x = cvt_pk_bf16(gelu_t(v0.x), gelu_t(v0.y)); w.y = cvt_pk_bf16(gelu_t(v0.z), gelu_t(v0.w)); w.z = cvt_pk_bf16(gelu_t(v1.x), gelu_t(v1.y)); w.w = cvt_pk_bf16(gelu_t(v1.z), gelu_t(v1.w)); }
                    else { w.x = cvt_pk_bf16(v0.x, v0.y); w.y = cvt_pk_bf16(v0.z, v0.w); w.z = cvt_pk_bf16(v1.x, v1.y); w.w = cvt_pk_bf16(v1.z, v1.w); }
                    *(v4u*)(rowp + bj * 128) = w; }
                asm volatile("" ::: "memory"); }
    }
};
struct EpiGlu {
    static constexpr bool PERM = true, AFTER_DRAIN = false;
    const bf16* ys; bf16* cat; const float* bias;
    __device__ __forceinline__ void operator()(const f32x4 (&acc)[2][2][4][2], const Unit& u, int wr, int wc, int fr, int fq) const {
        const int row0 = u.pm * 256 + wr * 64 + fr, col0 = u.pn * 256 + wc * 32 + 8 * fq;
        f32x4 bv[2][2];
#pragma unroll
        for (int bj = 0; bj < 2; ++bj)
#pragma unroll
            for (int n = 0; n < 2; ++n) bv[bj][n] = *(const f32x4*)(bias + col0 + bj * 128 + 4 * n);
#pragma unroll
        for (int ai = 0; ai < 2; ++ai)
#pragma unroll
            for (int m = 0; m < 4; ++m) { const size_t r = (size_t)(row0 + ai * 128 + m * 16);
#pragma unroll
                for (int bj = 0; bj < 2; ++bj) { const f32x4 g0 = acc[ai][bj][m][0] + bv[bj][0], g1 = acc[ai][bj][m][1] + bv[bj][1];
                    const v4u y = *(const v4u*)(ys + r * 512 + col0 + bj * 128);
                    v4u w;
                    w.x = cvt_pk_bf16(bflo(y.x) * sigm(g0[0]), bfhi(y.x) * sigm(g0[1])); w.y = cvt_pk_bf16(bflo(y.y) * sigm(g0[2]), bfhi(y.y) * sigm(g0[3]));
                    w.z = cvt_pk_bf16(bflo(y.z) * sigm(g1[0]), bfhi(y.z) * sigm(g1[1])); w.w = cvt_pk_bf16(bflo(y.w) * sigm(g1[2]), bfhi(y.w) * sigm(g1[3]));
                    *(v4u*)(cat + r * 1024 + col0 + bj * 128) = w; } }
    }
};
struct EpiRes {
    static constexpr bool PERM = false, AFTER_DRAIN = false;
    const float* bp; const float* bs; const float* gate  ; float* out;
    __device__ __forceinline__ void operator()(const f32x4 (&acc)[2][2][4][2], const Unit& u, int wr, int wc, int fr, int fq) const {
        const int col0 = u.pn * 256 + wc * 32 + 4 * fq;
#pragma unroll
        for (int ai = 0; ai < 2; ++ai)
#pragma unroll
            for (int m = 0; m < 4; ++m) { const int rl_ = ai * 128 + wr * 64 + m * 16 + fr; const int row = u.pm * 256 + rl_;
                const float* brow = row < SEQ ? bp + (size_t)row * D : bs + (size_t)(row - SEQ) * D;
                const int mr = row < SEQ ? 0 : 1 + ((row - SEQ) >> 5);
                const float* grow = gate + (size_t)mr * NMOD;
#pragma unroll
                for (int bj = 0; bj < 2; ++bj)
#pragma unroll
                    for (int n = 0; n < 2; ++n) { const int c = col0 + bj * 128 + n * 16;
                        const f32x4 b = *(const f32x4*)(brow + c), g = *(const f32x4*)(grow + c);
                        *(f32x4*)(out + (size_t)row * D + c) = b + g * acc[ai][bj][m][n]; }
                asm volatile("" ::: "memory"); }
    }
};
struct EpiGU {
    static constexpr bool PERM = true, AFTER_DRAIN = false;
    bf16* hid;
    __device__ __forceinline__ void operator()(const f32x4 (&acc)[2][2][4][2], const Unit& u, int wr, int wc, int fr, int fq) const {
        const int row0 = u.pm * 256 + wr * 64 + fr, col0 = u.pn * 128 + wc * 32 + 8 * fq;
#pragma unroll
        for (int ai = 0; ai < 2; ++ai)
#pragma unroll
            for (int m = 0; m < 4; ++m) { bf16* rowp = hid + (size_t)(row0 + ai * 128 + m * 16) * DFF + col0;
                const f32x4 g0 = acc[ai][0][m][0], g1 = acc[ai][0][m][1], u0 = acc[ai][1][m][0], u1 = acc[ai][1][m][1];
                v4u w; w.x = cvt_pk_bf16(silu_f(g0[0]) * u0[0], silu_f(g0[1]) * u0[1]); w.y = cvt_pk_bf16(silu_f(g0[2]) * u0[2], silu_f(g0[3]) * u0[3]);
                w.z = cvt_pk_bf16(silu_f(g1[0]) * u1[0], silu_f(g1[1]) * u1[1]); w.w = cvt_pk_bf16(silu_f(g1[2]) * u1[2], silu_f(g1[3]) * u1[3]);
                *(v4u*)rowp = w; }
    }
};

#define MFMA32(a, b, c) __builtin_amdgcn_mfma_f32_32x32x16_bf16((a), (b), (c), 0, 0, 0)
#define MFMA16(a, b, c) __builtin_amdgcn_mfma_f32_16x16x32_bf16((a), (b), (c), 0, 0, 0)
template <bool FULL>
__device__ __forceinline__ void s5_phase(const Args& a, LAS unsigned char* sbuf, int vw, int NGW, int lane, int nitems) {
    const int half = lane >> 5, x = lane & 31, l15 = lane & 15, q4 = lane >> 4;
    const bf16* ZS5 = (const bf16*)(a.ws + WS_ZS5);
    const bf16* TB = (const bf16*)(a.ws + WS_TB); const float* TA = (const float*)(a.ws + WS_TA); const bf16* TC = (const bf16*)(a.ws + WS_TC);
    bf16* YS = (bf16*)(a.ws + WS_YS);
    int curg = -1;
    bf16x8 tb[4], tc[4]; f32x4 ta[2][2]; f32x4 dd;
    int it = vw; if (it >= nitems) return;
    bf16x8 un = *(const bf16x8*)(ZS5 + (size_t)((it >> 5) * 32 + x) * 512 + (it & 31) * 16 + half * 8);
    for (; it < nitems; it += NGW) {
        const int g = it & 31, ch = it >> 5, m0 = ch * 32;
        if (g != curg) { curg = g;
#pragma unroll
            for (int c = 0; c < 4; ++c) tb[c] = *(const bf16x8*)(TB + (size_t)(g * 128 + c * 32 + x) * 16 + half * 8);
#pragma unroll
            for (int s = 0; s < 2; ++s) { ta[s][0] = *(const f32x4*)(TA + (size_t)(g * 64 + 2 * x + s) * 8); ta[s][1] = *(const f32x4*)(TA + (size_t)(g * 64 + 2 * x + s) * 8 + 4); }
            if (FULL) {
#pragma unroll
                for (int ks = 0; ks < 4; ++ks) tc[ks] = *(const bf16x8*)(TC + (size_t)(g * 16 + l15) * 128 + ks * 32 + q4 * 8);
                dd = *(const f32x4*)(a.in[18] + g * 16 + q4 * 4); }
        }
        const bf16x8 ua = un;
        { const int nx = it + NGW; if (nx < nitems) un = *(const bf16x8*)(ZS5 + (size_t)((nx >> 5) * 32 + x) * 512 + (nx & 31) * 16 + half * 8); }
        float cin0r = 0.f, cin0i = 0.f, cin1r = 0.f, cin1i = 0.f;
        if (FULL) {
            if (ch >= 512) { const int b = ch - 512; const f32x2 r2 = *(const f32x2*)(a.in[2] + (size_t)(b * 32 + g) * 64 + 2 * x), i2 = *(const f32x2*)(a.in[3] + (size_t)(b * 32 + g) * 64 + 2 * x);
                cin0r = r2.x; cin1r = r2.y; cin0i = i2.x; cin1i = i2.y; }
            else if (ch > 0) { const float* sst = (const float*)(a.ws + WS_SST) + (size_t)(ch * 32 + g) * 128; const f32x2 r2 = *(const f32x2*)(sst + 2 * x), i2 = *(const f32x2*)(sst + 64 + 2 * x);
                cin0r = r2.x; cin1r = r2.y; cin0i = i2.x; cin1i = i2.y; }
        }
        v2u uu[2];
        if (FULL) {
#pragma unroll
            for (int tt = 0; tt < 2; ++tt) uu[tt] = *(const v2u*)(ZS5 + (size_t)(m0 + tt * 16 + l15) * 512 + g * 16 + q4 * 4); }
        f32x16 acc[4];
#pragma unroll
        for (int c = 0; c < 4; ++c) { f32x16 z;
#pragma unroll
            for (int r = 0; r < 16; ++r) z[r] = 0.f;
            acc[c] = MFMA32(ua, tb[c], z); }
        float endr[2], endi[2];
#pragma unroll
        for (int s = 0; s < 2; ++s) {
            const f32x4 t0 = ta[s][0], t1 = ta[s][1];
            const float apr[4] = {t0.x, t0.z, t1.x, t1.z}, api[4] = {t0.y, t0.w, t1.y, t1.w};
            const float a1r = apr[0], a1i = api[0], a4r = apr[3], a4i = api[3];
            f32x16& R = acc[s]; f32x16& I = acc[2 + s];
#pragma unroll
            for (int i = 0; i < 4; ++i)
#pragma unroll
                for (int j = 1; j < 4; ++j) { const int r = 4 * i + j; const float pr = R[r - 1], pi = I[r - 1];
                    R[r] += a1r * pr - a1i * pi; I[r] += a1r * pi + a1i * pr; }
            float cr = s ? cin1r : cin0r, ci = s ? cin1i : cin0i;
            float cinr[4], cini[4];
#pragma unroll
            for (int i = 0; i < 4; ++i) {
                const float lr_ = R[4 * i + 3], li_ = I[4 * i + 3];
                const float candr = a4r * cr - a4i * ci + lr_, candi = a4r * ci + a4i * cr + li_;
                const float othr = __shfl_xor(candr, 32), othi = __shfl_xor(candi, 32);
                cinr[i] = half ? othr : cr; cini[i] = half ? othi : ci;
                const float outr = a4r * cinr[i] - a4i * cini[i] + lr_, outi = a4r * cini[i] + a4i * cinr[i] + li_;
                cr = __shfl_xor(outr, 32); ci = __shfl_xor(outi, 32);
            }
            endr[s] = cr; endi[s] = ci;
            if (FULL) {
#pragma unroll
                for (int i = 0; i < 4; ++i)
#pragma unroll
                    for (int j = 0; j < 4; ++j) { const int r = 4 * i + j;
                        R[r] += apr[j] * cinr[i] - api[j] * cini[i]; I[r] += apr[j] * cini[i] + api[j] * cinr[i]; }
            }
        }
        if (!FULL) {
            if (half == 0) { float* sl = (float*)(a.ws + WS_SLOC) + (size_t)(ch * 32 + g) * 128;
                *(f32x2*)(sl + 2 * x) = (f32x2){endr[0], endr[1]}; *(f32x2*)(sl + 64 + 2 * x) = (f32x2){endi[0], endi[1]}; }
            continue;
        }
        if (half == 0 && ch >= 511) {
            float* ore = ch == 511 ? a.out + O_PRE + g * 64 : a.out + O_SRE + (size_t)((ch - 512) * 32 + g) * 64;
            float* oim = ch == 511 ? a.out + O_PIM + g * 64 : a.out + O_SIM + (size_t)((ch - 512) * 32 + g) * 64;
            *(f32x2*)(ore + 2 * x) = (f32x2){endr[0], endr[1]}; *(f32x2*)(oim + 2 * x) = (f32x2){endi[0], endi[1]};
        }
#pragma unroll
        for (int r = 0; r < 16; ++r) { const int t = (r & 3) + 8 * (r >> 2) + 4 * half;
            *(LAS unsigned*)(sbuf + t * 272 + 4 * x) = cvt_pk_bf16(acc[0][r], acc[1][r]);
            *(LAS unsigned*)(sbuf + t * 272 + 128 + 4 * x) = cvt_pk_bf16(acc[2][r], acc[3][r]); }
        LDS_WAIT();
        f32x4 y[2] = {(f32x4){0.f, 0.f, 0.f, 0.f}, (f32x4){0.f, 0.f, 0.f, 0.f}};
#pragma unroll
        for (int ks = 0; ks < 4; ++ks) {
#pragma unroll
            for (int tt = 0; tt < 2; ++tt) { const bf16x8 sb = *(const LAS bf16x8*)(sbuf + (tt * 16 + l15) * 272 + (ks * 32 + q4 * 8) * 2); y[tt] = MFMA16(tc[ks], sb, y[tt]); } }
        LDS_WAIT();
#pragma unroll
        for (int tt = 0; tt < 2; ++tt) { const size_t off = (size_t)(m0 + tt * 16 + l15) * 512 + g * 16 + q4 * 4;
            const float o0 = gelu_t(y[tt][0] + dd[0] * bflo(uu[tt].x)), o1 = gelu_t(y[tt][1] + dd[1] * bfhi(uu[tt].x)), o2 = gelu_t(y[tt][2] + dd[2] * bflo(uu[tt].y)), o3 = gelu_t(y[tt][3] + dd[3] * bfhi(uu[tt].y));
            v2u w; w.x = cvt_pk_bf16(o0, o1); w.y = cvt_pk_bf16(o2, o3); *(v2u*)(YS + off) = w; }
    }
}

__device__ __forceinline__ void s5_chunk_scan(const Args& a, int g, LAS unsigned char* lds, int tid) {
    const int n = tid & 63, seg = tid >> 6;
    const float* TP = (const float*)(a.ws + WS_TP) + (size_t)(g * 64 + n) * 4;
    const float pr = TP[0], pi = TP[1], qr = TP[2], qi = TP[3];
    const float* sl = (const float*)(a.ws + WS_SLOC) + (size_t)(seg * 64) * 4096 + g * 128 + n;
    float* st = (float*)(a.ws + WS_SST) + (size_t)(seg * 64) * 4096 + g * 128 + n;
    float vr = 0.f, vi = 0.f;
#pragma unroll 8
    for (int k = 0; k < 64; ++k) { const float lr_ = sl[(size_t)k * 4096], li_ = sl[(size_t)k * 4096 + 64]; const float t = pr * vr - pi * vi + lr_; vi = pr * vi + pi * vr + li_; vr = t; }
    LAS f32x2* agg = (LAS f32x2*)lds;
    agg[seg * 64 + n] = (f32x2){vr, vi};
    __syncthreads();
    float cr = 0.f, ci = 0.f;
    for (int s = 0; s < seg; ++s) { const f32x2 ag = agg[s * 64 + n]; const float t = qr * cr - qi * ci + ag.x; ci = qr * ci + qi * cr + ag.y; cr = t; }
    vr = cr; vi = ci;
#pragma unroll 8
    for (int k = 0; k < 64; ++k) { st[(size_t)k * 4096] = vr; st[(size_t)k * 4096 + 64] = vi;
        const float lr_ = sl[(size_t)k * 4096], li_ = sl[(size_t)k * 4096 + 64]; const float t = pr * vr - pi * vi + lr_; vi = pr * vi + pi * vr + li_; vr = t; }
    __syncthreads();
}

__device__ __forceinline__ void ln_stats(const Args& a, int vw, int NGW, int lane) {
    const bf16* GV = (const bf16*)(a.ws + WS_GV); f32x2* ST = (f32x2*)(a.ws + WS_STATS);
#pragma unroll 2
    for (int m = vw; m < M; m += NGW) {
        const v4u rw = *(const v4u*)(GV + (size_t)m * 512 + 8 * lane); const unsigned wv[4] = {rw.x, rw.y, rw.z, rw.w};
        float s = 0.f, q = 0.f;
#pragma unroll
        for (int e = 0; e < 4; ++e) { const float d0 = bflo(wv[e]), d1 = bfhi(wv[e]); s += d0 + d1; q += d0 * d0 + d1 * d1; }
        s = wave_sum(s); q = wave_sum(q);
        const float mean = s * (1.0f / 512.0f), rstd = 1.0f / sqrtf(fmaxf(q * (1.0f / 512.0f) - mean * mean, 0.f) + EPS);
        if (lane == 0) ST[m] = (f32x2){mean, rstd};
    }
}
template <int NKS>
__device__ __forceinline__ void gmlp_tile(const float* W, const float* BS, LAS unsigned char* vt, const bf16* UG, bf16* CAT, int m0, int h, int itile, int lane) {
    constexpr int VP = 272;
    const int half = lane >> 5, x = lane & 31, i = 32 * itile + x;
    bf16x8 bfr[NKS];
#pragma unroll
    for (int ks = 0; ks < NKS; ++ks) { const float* wp = W + (size_t)i * 128 + 16 * ks + 8 * half;
        const f32x4 w0 = *(const f32x4*)wp, w1 = *(const f32x4*)(wp + 4);
        v4u wb; wb.x = cvt_pk_bf16(w0.x, w0.y); wb.y = cvt_pk_bf16(w0.z, w0.w); wb.z = cvt_pk_bf16(w1.x, w1.y); wb.w = cvt_pk_bf16(w1.z, w1.w);
        bfr[ks] = __builtin_bit_cast(bf16x8, wb); }
    const float bsv = BS[i];
    v2u uu[2][4];
#pragma unroll
    for (int ct = 0; ct < 2; ++ct)
#pragma unroll
        for (int rq = 0; rq < 4; ++rq) uu[ct][rq] = *(const v2u*)(UG + (size_t)(m0 + i) * 512 + h * 64 + 32 * ct + 8 * rq + 4 * half);
    f32x16 acc[2];
#pragma unroll
    for (int r = 0; r < 16; ++r) { acc[0][r] = 0.f; acc[1][r] = 0.f; }
#pragma unroll
    for (int ks = 0; ks < NKS; ++ks)
#pragma unroll
        for (int ct = 0; ct < 2; ++ct) { const bf16x8 af = *(const LAS bf16x8*)(vt + (32 * ct + x) * VP + (16 * ks + 8 * half) * 2); acc[ct] = MFMA32(af, bfr[ks], acc[ct]); }
#pragma unroll
    for (int ct = 0; ct < 2; ++ct)
#pragma unroll
        for (int rq = 0; rq < 4; ++rq) { const int c0 = h * 64 + 32 * ct + 8 * rq + 4 * half; const v2u u2 = uu[ct][rq];
            const float o0 = bflo(u2.x) * (acc[ct][4 * rq + 0] + bsv), o1 = bfhi(u2.x) * (acc[ct][4 * rq + 1] + bsv), o2 = bflo(u2.y) * (acc[ct][4 * rq + 2] + bsv), o3 = bfhi(u2.y) * (acc[ct][4 * rq + 3] + bsv);
            v2u w; w.x = cvt_pk_bf16(o0, o1); w.y = cvt_pk_bf16(o2, o3);
            *(v2u*)(CAT + (size_t)(m0 + i) * 1024 + 512 + c0) = w; }
}
__device__ __forceinline__ void gmlp_item(const Args& a, int ck, int h, LAS unsigned char* vt, int lane) {
    constexpr int VP = 272;
    const int m0 = ck < 128 ? ck * 128 : SEQ + (ck - 128) * 32, ntok = ck < 128 ? 128 : 32;
    const bf16* GV = (const bf16*)(a.ws + WS_GV); const bf16* UG = (const bf16*)(a.ws + WS_UG); bf16* CAT = (bf16*)(a.ws + WS_CAT);
    const f32x2* ST = (const f32x2*)(a.ws + WS_STATS);
    const float* lg = a.in[21] + h * 64; const float* lb = a.in[22] + h * 64;
#pragma unroll
    for (int tp = 0; tp < 2; ++tp) { const int tk = lane + 64 * tp;
        if (tk < ntok) {
            const f32x2 st = ST[m0 + tk]; const float mean = st.x, rstd = st.y;
            const bf16* src = GV + (size_t)(m0 + tk) * 512 + h * 64;
            float* vout = (ck >= 128) ? a.out + O_V + (size_t)((ck - 128) * 32 + tk) * 512 + h * 64 : nullptr;
            v4u rw[8];
#pragma unroll
            for (int i = 0; i < 8; ++i) rw[i] = *(const v4u*)(src + 8 * i);
#pragma unroll
            for (int i = 0; i < 8; ++i) { const unsigned wv[4] = {rw[i].x, rw[i].y, rw[i].z, rw[i].w};
                const f32x4 g0 = *(const f32x4*)(lg + 8 * i), g1 = *(const f32x4*)(lg + 8 * i + 4), b0 = *(const f32x4*)(lb + 8 * i), b1 = *(const f32x4*)(lb + 8 * i + 4);
                const float gq[8] = {g0.x, g0.y, g0.z, g0.w, g1.x, g1.y, g1.z, g1.w}, bq[8] = {b0.x, b0.y, b0.z, b0.w, b1.x, b1.y, b1.z, b1.w};
                float vv[8];
#pragma unroll
                for (int e = 0; e < 4; ++e) { vv[2 * e] = (bflo(wv[e]) - mean) * rstd * gq[2 * e] + bq[2 * e]; vv[2 * e + 1] = (bfhi(wv[e]) - mean) * rstd * gq[2 * e + 1] + bq[2 * e + 1]; }
                if (vout) { *(f32x4*)(vout + 8 * i) = (f32x4){vv[0], vv[1], vv[2], vv[3]}; *(f32x4*)(vout + 8 * i + 4) = (f32x4){vv[4], vv[5], vv[6], vv[7]}; }
#pragma unroll
                for (int e = 0; e < 8; ++e) *(LAS unsigned short*)(vt + (8 * i + e) * VP + tk * 2) = (unsigned short)(cvt_pk_bf16(vv[e], 0.f) & 0xffffu);
            }
        }
    }
    LDS_WAIT();
    const float* W = a.in[23] + (size_t)h * 128 * 128; const float* BS = a.in[24] + h * 128;
    if (ntok == 128) {
        gmlp_tile<4>(W, BS, vt, UG, CAT, m0, h, 0, lane); gmlp_tile<4>(W, BS, vt, UG, CAT, m0, h, 1, lane);
        gmlp_tile<8>(W, BS, vt, UG, CAT, m0, h, 2, lane); gmlp_tile<8>(W, BS, vt, UG, CAT, m0, h, 3, lane);
    } else gmlp_tile<2>(W, BS, vt, UG, CAT, m0, h, 0, lane);
    LDS_WAIT();
}

__device__ __forceinline__ void skinny_sample(const bf16* A, const bf16* WT, int K, const float* base, const float* gate, float* out, int unit, int wave, int lane) {
    const int rh = unit >> 6, cs = unit & 63, l15 = lane & 15, q4 = lane >> 4;
    const int row = rh * 128 + wave * 16 + l15, c0 = cs * 16;
    const bf16* ap = A + (size_t)row * K + q4 * 8; const bf16* bp = WT + (size_t)(c0 + l15) * K + q4 * 8;
    f32x4 acc0 = (f32x4){0.f, 0.f, 0.f, 0.f}, acc1 = acc0;
#pragma unroll 4
    for (int k = 0; k < K; k += 64) {
        const bf16x8 a0 = *(const bf16x8*)(ap + k), b0 = *(const bf16x8*)(bp + k), a1 = *(const bf16x8*)(ap + k + 32), b1 = *(const bf16x8*)(bp + k + 32);
        acc0 = MFMA16(b0, a0, acc0); acc1 = MFMA16(b1, a1, acc1); }
    const f32x4 acc = acc0 + acc1;
    const int mr = 1 + (row >> 5), c = c0 + q4 * 4;
    const f32x4 b = *(const f32x4*)(base + (size_t)row * D + c), g = *(const f32x4*)(gate + (size_t)mr * NMOD + c);
    *(f32x4*)(out + (size_t)row * D + c) = b + g * acc;
}

__global__ void __launch_bounds__(512, 2) mega(Args a) {
    extern __shared__ __attribute__((aligned(16))) unsigned char lds_raw[];
    LAS unsigned char* lds = (LAS unsigned char*)lds_raw;
    cg::grid_group grid = cg::this_grid();
    const int tid = threadIdx.x, lane = tid & 63, wave = __builtin_amdgcn_readfirstlane(tid >> 6);
    const int G = gridDim.x, bx = blockIdx.x;
    const int vw = wave * G + bx, NGW = G * 8;
    const int lo = a.ph_lo, hi = a.ph_hi;
    volatile LAS unsigned* xst = (volatile LAS unsigned*)(lds + LDS_BYTES - 64);
    if (tid < 16) xst[tid] = 0u;
    __syncthreads();
    const XcdBarrier xbar = xcd_barrier_post((unsigned*)a.ws, xst);
    if (hi > 1000) grid.sync();
#ifndef REPMASK
#define REPMASK 0
#endif
#ifndef PHMASK
#define PHMASK 0xfff
#endif
#define IN(k) ((((PHMASK) >> (k)) & 1) && lo <= (k) && (k) < hi)
#define SEAM(k) do { if (IN(k) && IN((k) + 1)) xcd_barrier(xbar); } while (0)

    if (IN(0)) for (int rep = 0; rep <= ((REPMASK >> 0) & 1); ++rep) { if (rep) xcd_barrier(xbar); p0_prologue(a, lds, vw, NGW, wave, lane); }
    SEAM(0);
    if (IN(1)) for (int rep = 0; rep <= ((REPMASK >> 1) & 1); ++rep) { if (rep) xcd_barrier(xbar);
        float* modf = (float*)(a.ws + WS_MODF); const float* modp = (const float*)(a.ws + WS_MODP);
        for (int i = bx * 512 + tid; i < 9 * NMOD; i += G * 512) { float s = a.in[9][i % NMOD];
#pragma unroll
            for (int ks = 0; ks < NKS; ++ks) s += modp[(size_t)ks * 9 * NMOD + i];
            modf[i] = s; }
        hprep<0>(a, vw, NGW, lane);
    }
    SEAM(1);
    if (IN(2)) for (int rep = 0; rep <= ((REPMASK >> 2) & 1); ++rep) { if (rep) xcd_barrier(xbar);
        pg8::Gemm g{(const bf16*)(a.ws + WS_H), (const bf16*)(a.ws + WS_WIN), M, INW, D}; pg8::StaticOrder S; S.init(M, INW, G, bx);
        EpiIn E{(bf16*)(a.ws + WS_ZS5), (bf16*)(a.ws + WS_UG), (bf16*)(a.ws + WS_GV)};
        pg8::gemm_phase<EpiIn, pg8::StaticOrder, true, true>(lds, g, S, E);
    }
    SEAM(2);
    if (IN(3)) for (int rep = 0; rep <= ((REPMASK >> 3) & 1); ++rep) { if (rep) xcd_barrier(xbar);
        ln_stats(a, vw, NGW, lane);
        s5_phase<false>(a, lds + wave * 8704, vw, NGW, lane, 512 * 32);
    }
    SEAM(3);
    if (IN(4)) for (int rep = 0; rep <= ((REPMASK >> 4) & 1); ++rep) { if (rep) xcd_barrier(xbar);
        for (int g = bx; g < 32; g += G) s5_chunk_scan(a, g, lds, tid);
        { const int gb = G > 64 ? 32 : 0; if (bx >= gb) for (int it = wave * (G - gb) + (bx - gb); it < 136 * 8; it += (G - gb) * 8) gmlp_item(a, it >> 3, it & 7, lds + wave * 17408, lane); }
    }
    SEAM(4);
    if (IN(5)) for (int rep = 0; rep <= ((REPMASK >> 5) & 1); ++rep) { if (rep) xcd_barrier(xbar);
        s5_phase<true>(a, lds + wave * 8704, vw, NGW, lane, NCH * 32);
    }
    SEAM(5);
    if (IN(6)) for (int rep = 0; rep <= ((REPMASK >> 6) & 1); ++rep) { if (rep) xcd_barrier(xbar);
        pg8::Gemm g{(const bf16*)(a.ws + WS_YS), (const bf16*)(a.ws + WS_WGLU), M, 512, 512}; pg8::StaticOrder S; S.init(M, 512, G, bx);
        EpiGlu E{(const bf16*)(a.ws + WS_YS), (bf16*)(a.ws + WS_CAT), a.in[20]};
        pg8::gemm_phase<EpiGlu, pg8::StaticOrder, true, true>(lds, g, S, E);
    }
    SEAM(6);
    if (IN(7)) for (int rep = 0; rep <= ((REPMASK >> 7) & 1); ++rep) { if (rep) xcd_barrier(xbar);
        pg8::Gemm g{(const bf16*)(a.ws + WS_CAT), (const bf16*)(a.ws + WS_WOUT), SEQ, D, D}; pg8::StaticOrder S; S.init(SEQ, D, G, bx);
        EpiRes E{a.in[0], a.in[1], (const float*)(a.ws + WS_MODF) + 2 * D, (float*)(a.ws + WS_X1)};
        pg8::gemm_phase<EpiRes, pg8::StaticOrder, true, true>(lds, g, S, E);
        for (int u = bx; u < 128; u += G) skinny_sample((const bf16*)(a.ws + WS_CAT) + (size_t)SEQ * D, (const bf16*)(a.ws + WS_WOUT), D, a.in[1], (const float*)(a.ws + WS_MODF) + 2 * D, (float*)(a.ws + WS_X1) + (size_t)SEQ * D, u, wave, lane);
    }
    SEAM(7);
    if (IN(8)) for (int rep = 0; rep <= ((REPMASK >> 8) & 1); ++rep) { if (rep) xcd_barrier(xbar); hprep<1>(a, vw, NGW, lane); }
    SEAM(8);
    if (IN(9)) for (int rep = 0; rep <= ((REPMASK >> 9) & 1); ++rep) { if (rep) xcd_barrier(xbar);
        pg8::Gemm g{(const bf16*)(a.ws + WS_H), (const bf16*)(a.ws + WS_WGU), M, GUW, D}; pg8::StaticOrder S; S.init(M, GUW, G, bx);
        EpiGU E{(bf16*)(a.ws + WS_HID)};
        pg8::gemm_phase<EpiGU, pg8::StaticOrder, true, true>(lds, g, S, E);
    }
    SEAM(9);
    if (IN(10)) for (int rep = 0; rep <= ((REPMASK >> 10) & 1); ++rep) { if (rep) xcd_barrier(xbar);
        pg8::Gemm g{(const bf16*)(a.ws + WS_HID), (const bf16*)(a.ws + WS_WD), SEQ, D, DFF}; pg8::StaticOrder S; S.init(SEQ, D, G, bx);
        const float* x1 = (const float*)(a.ws + WS_X1);
        EpiRes E{x1, x1 + (size_t)SEQ * D, (const float*)(a.ws + WS_MODF) + 5 * D, a.out};
        pg8::gemm_phase<EpiRes, pg8::StaticOrder, true, true>(lds, g, S, E);
        for (int u = bx; u < 128; u += G) skinny_sample((const bf16*)(a.ws + WS_HID) + (size_t)SEQ * DFF, (const bf16*)(a.ws + WS_WD), DFF, x1 + (size_t)SEQ * D, (const float*)(a.ws + WS_MODF) + 5 * D, a.out + (size_t)SEQ * D, u, wave, lane);
    }
    SEAM(10);
    if (IN(11)) for (int rep = 0; rep <= ((REPMASK >> 11) & 1); ++rep) { if (rep) xcd_barrier(xbar);
        const float* fg = a.in[28];
        f32x4 gg[4];
#pragma unroll
        for (int j = 0; j < 4; ++j) gg[j] = *(const f32x4*)(fg + 4 * lane + 256 * j);
        f32x4 vn[4];
        if (vw < M) {
#pragma unroll
            for (int j = 0; j < 4; ++j) vn[j] = *(const f32x4*)(a.out + (size_t)vw * D + 4 * lane + 256 * j); }
        for (int m = vw; m < M; m += NGW) { float* row = a.out + (size_t)m * D;
            f32x4 v[4]; float ss = 0.f;
#pragma unroll
            for (int j = 0; j < 4; ++j) v[j] = vn[j];
            if (m + NGW < M) {
#pragma unroll
                for (int j = 0; j < 4; ++j) vn[j] = *(const f32x4*)(row + (size_t)NGW * D + 4 * lane + 256 * j); }
#pragma unroll
            for (int j = 0; j < 4; ++j) ss += (v[j].x * v[j].x + v[j].y * v[j].y) + (v[j].z * v[j].z + v[j].w * v[j].w);
            const float rstd = 1.0f / sqrtf(wave_sum(ss) * (1.0f / D) + EPS);
#pragma unroll
            for (int j = 0; j < 4; ++j) *(f32x4*)(row + 4 * lane + 256 * j) = v[j] * rstd * gg[j]; }
    }
#undef IN
#undef SEAM
}

#ifndef MK_PER_PHASE
#define MK_PER_PHASE 0
#endif
extern "C" void kernel_launch(void* const* d_in, const int* in_sizes, int n_in, void* d_out, int out_size, void* d_ws, size_t ws_size, hipStream_t stream) {
    static int grid = 0;
    if (grid == 0) {
        int dev = 0, cus = 0, per_cu = 0;
        if (n_in != 29 || ws_size < WS_END) { fprintf(stderr, "kernel_launch: unexpected n_in %d / ws %zu\n", n_in, ws_size); grid = -1; return; }
        hipGetDevice(&dev); hipDeviceGetAttribute(&cus, hipDeviceAttributeMultiprocessorCount, dev);
        hipFuncSetAttribute((const void*)mega, hipFuncAttributeMaxDynamicSharedMemorySize, LDS_BYTES);
        hipOccupancyMaxActiveBlocksPerMultiprocessor(&per_cu, (const void*)mega, 512, LDS_BYTES);
        if (per_cu < 1) { fprintf(stderr, "kernel_launch: occupancy query says %d blocks/CU\n", per_cu); per_cu = 1; }
        (void)hipGetLastError();
        grid = cus * 1;
    }
    if (grid < 0) return;
    Args a{};
    for (int i = 0; i < 29; ++i) a.in[i] = (const float*)d_in[i];
    a.out = (float*)d_out; a.ws = (unsigned char*)d_ws;
    a.ph_lo = 0; a.ph_hi = NPH;
    if (hipMemsetAsync(d_ws, 0, 16384, stream) != hipSuccess) { fprintf(stderr, "kernel_launch: memset of the barrier words failed\n"); return; }
    void* args[] = {&a};
    hipError_t e = hipLaunchCooperativeKernel((const void*)mega, dim3(grid), dim3(512), args, LDS_BYTES, stream);
    if (e != hipSuccess) fprintf(stderr, "cooperative launch failed: %s (grid %d)\n", hipGetErrorString(e), grid);
}
```

```cpp
#include <hip/hip_runtime.h>
#include <hip/hip_cooperative_groups.h>
#include <cstdio>
#include <cstdint>
namespace cg = cooperative_groups;
namespace pg8 {
#define PG8_LAS __attribute__((address_space(3)))
typedef unsigned short bf16_t;
typedef short bf16x8 __attribute__((ext_vector_type(8)));
typedef float f32x4 __attribute__((ext_vector_type(4)));
typedef unsigned u32x4 __attribute__((ext_vector_type(4)));
constexpr int BM = 256, BK = 64, HALF = 128, HTB = HALF * BK * 2  , STAGE_BYTES = 8 * HTB, NXCD = 8, WGM = 8;

__host__ __device__ __forceinline__ int lds_byte(int r, int c) { const int st = (r >> 4) * 2 + (c >> 5), rr = r & 15, cc = c & 31, ob = rr * 64 + cc * 2; return st * 1024 + (ob ^ (((ob >> 9) & 1) << 5)); }
__host__ __device__ __forceinline__ void stage_rc(int b, int& R, int& C) { const int st = b / 1024, sb = b % 1024, swz = sb ^ (((sb >> 9) & 1) << 5); R = (st >> 1) * 16 + swz / 64; C = (st & 1) * 32 + (swz % 64) / 2; }
__host__ __device__ __forceinline__ int perm32(int rho) { const int n = rho >> 4, i = rho & 15; return 8 * (i >> 2) + 4 * n + (i & 3); }

struct Unit { int pm, pn; };
struct Gemm { const bf16_t* A; const bf16_t* Bt; int M, N, K; };

struct StaticOrder {
    int nM, nN, nwg, G, c;
    __host__ __device__ void init(int M, int N, int G_, int c_) { nM = M / BM; nN = N / BM; nwg = nM * nN; G = G_; c = c_; }
    __host__ __device__ bool next(int i, Unit& u) const {
        const long L = (long)i * G + c; if (L >= nwg) return false;
        int wgid = (int)L; { const int q = nwg / NXCD, r = nwg % NXCD, xcd = wgid % NXCD, off = wgid / NXCD; wgid = (xcd < r ? xcd * (q + 1) : r * (q + 1) + (xcd - r) * q) + off; }
        const int nig = WGM * nN, gid = wgid / nig, fm = gid * WGM, gsz = (nM - fm) < WGM ? (nM - fm) : WGM;
        u.pm = fm + ((wgid % nig) % gsz); u.pn = (wgid % nig) / gsz; return true;
    }
    __device__ __forceinline__ void a_ready(const Unit&) const {}
    __device__ __forceinline__ void done(const Unit&) const {}
};
__device__ __forceinline__ unsigned cvt_pk_bf16(float lo, float hi) { unsigned r; asm volatile("v_cvt_pk_bf16_f32 %0, %1, %2" : "=v"(r) : "v"(lo), "v"(hi)); return r; }
template <class Epi, class Sched, bool ALIGN_EPI = false, bool SP2 = false>
__device__ __forceinline__ void gemm_phase(PG8_LAS unsigned char* lds, const Gemm g, const Sched& S, const Epi& E) {
    const int tid = threadIdx.x, wid = __builtin_amdgcn_readfirstlane(tid >> 6), lane = tid & 63, wr = wid >> 2, wc = wid & 3, fr = lane & 15, fq = lane >> 4;
    const int K = g.K, nt = K / BK;
    unsigned voffA[2], voffB[2];
#pragma unroll
    for (int i = 0; i < 2; ++i) { int R, C; stage_rc(tid * 16 + i * 8192, R, C); const int Rb = Epi::PERM ? ((R & ~31) + perm32(R & 31)) : R;
        voffA[i] = (unsigned)(R * K + C) * 2u; voffB[i] = (unsigned)(Rb * K + C) * 2u; }
    const size_t kstep = (size_t)(BK * 2);
    const size_t hstep = (size_t)HALF * K * 2;
    const size_t tstep = 2 * hstep;
    const unsigned ldsw = (unsigned)wid * 1024u;
    const int aoff = lds_byte(wr * 64 + fr, fq * 8), boff = lds_byte(wc * 32 + fr, fq * 8);
#define PG8_SA(b, h) (((b) * 2 + (h)) * HTB)
#define PG8_SB(b, h) ((4 + (b) * 2 + (h)) * HTB)
#define PG8_STAGE(bufoff, gbase, voff) do { _Pragma("unroll") for (int _i = 0; _i < 2; ++_i) \
        __builtin_amdgcn_global_load_lds((const unsigned*)((const char*)(gbase) + (voff)[_i]), (PG8_LAS unsigned*)(lds + (bufoff) + ldsw + _i * 8192), 16, 0, 0); } while (0)
#define PG8_LDA(dst, b, h) do { _Pragma("unroll") for (int m = 0; m < 4; ++m) _Pragma("unroll") for (int k = 0; k < 2; ++k) dst[m][k] = *(const PG8_LAS bf16x8*)(lds + PG8_SA(b, h) + aoff + m * 2048 + k * 1024); } while (0)
#define PG8_LDB(dst, b, h) do { _Pragma("unroll") for (int n = 0; n < 2; ++n) _Pragma("unroll") for (int k = 0; k < 2; ++k) dst[n][k] = *(const PG8_LAS bf16x8*)(lds + PG8_SB(b, h) + boff + n * 2048 + k * 1024); } while (0)
#define PG8_MMA(ai, bj, At, Bt) do { __builtin_amdgcn_s_setprio(1); _Pragma("unroll") for (int m = 0; m < 4; ++m) _Pragma("unroll") for (int n = 0; n < 2; ++n) _Pragma("unroll") for (int k = 0; k < 2; ++k) \
        acc[ai][bj][m][n] = __builtin_amdgcn_mfma_f32_16x16x32_bf16(Bt[n][k], At[m][k], acc[ai][bj][m][n], 0, 0, 0); __builtin_amdgcn_s_setprio(0); } while (0)
#define PG8_WAIT_V(n) asm volatile("s_waitcnt vmcnt(" #n ")" ::: "memory")
#define PG8_WAIT_L(n) asm volatile("s_waitcnt lgkmcnt(" #n ")" ::: "memory")
#define PG8_BAR __builtin_amdgcn_s_barrier()
#define PG8_SCHED __builtin_amdgcn_sched_barrier(0)
    Unit cur, nxt; int ui = 0;
    if (!S.next(0, cur)) return;
    f32x4 acc[2][2][4][2];
#pragma unroll
    for (int a = 0; a < 2; ++a)
#pragma unroll
        for (int b = 0; b < 2; ++b)
#pragma unroll
            for (int m = 0; m < 4; ++m)
#pragma unroll
                for (int n = 0; n < 2; ++n) acc[a][b][m][n] = (f32x4){0.f, 0.f, 0.f, 0.f};
    bf16x8 At[4][2], B0[2][2], B1[2][2];
    const char* cA = (const char*)g.A + (size_t)cur.pm * tstep; const char* cB = (const char*)g.Bt + (size_t)cur.pn * tstep;
    S.a_ready(cur);
    if constexpr (SP2) {
        PG8_STAGE(PG8_SB(0, 0), cB, voffB); PG8_STAGE(PG8_SB(0, 1), cB + hstep, voffB); PG8_STAGE(PG8_SA(0, 0), cA, voffA); PG8_STAGE(PG8_SA(0, 1), cA + hstep, voffA);
        if (wr == 1) PG8_BAR;
        PG8_WAIT_V(2); PG8_BAR;
        PG8_STAGE(PG8_SB(1, 0), cB + kstep, voffB); PG8_STAGE(PG8_SA(1, 0), cA + kstep, voffA); PG8_STAGE(PG8_SB(1, 1), cB + hstep + kstep, voffB);
        PG8_WAIT_V(6); PG8_BAR;
    } else {
        PG8_STAGE(PG8_SB(0, 0), cB, voffB); PG8_STAGE(PG8_SA(0, 0), cA, voffA); PG8_STAGE(PG8_SB(0, 1), cB + hstep, voffB); PG8_STAGE(PG8_SA(0, 1), cA + hstep, voffA);
        if (wr == 1) PG8_BAR;
        PG8_WAIT_V(4); PG8_BAR;
        PG8_STAGE(PG8_SB(1, 0), cB + kstep, voffB); PG8_STAGE(PG8_SA(1, 0), cA + kstep, voffA); PG8_STAGE(PG8_SB(1, 1), cB + hstep + kstep, voffB);
        PG8_WAIT_V(6); PG8_BAR;
    }
    for (;;) {
        const bool has_next = S.next(ui + 1, nxt);
        const char* nA = has_next ? (const char*)g.A + (size_t)nxt.pm * tstep : cA; const char* nB = has_next ? (const char*)g.Bt + (size_t)nxt.pn * tstep : cB;
        for (int t = 0; t < nt; t += 2) {
            const bool last = (t == nt - 2);
            const char* a1 = cA + (size_t)(t + 1) * kstep;
            const char* a2 = last ? nA : cA + (size_t)(t + 2) * kstep; const char* b2 = last ? nB : cB + (size_t)(t + 2) * kstep;
            const char* a3 = a2 + kstep; const char* b3 = b2 + kstep;
            if (last && has_next) S.a_ready(nxt);
            if constexpr (SP2) {
            PG8_LDB(B0, 0, 0); PG8_LDB(B1, 0, 1); PG8_SCHED; PG8_LDA(At, 0, 0); PG8_STAGE(PG8_SA(1, 1), a1 + hstep, voffA);
            PG8_WAIT_V(8); PG8_WAIT_L(0); PG8_BAR; PG8_MMA(0, 0, At, B0); PG8_MMA(0, 1, At, B1); PG8_BAR; PG8_SCHED;
            PG8_LDA(At, 0, 1); PG8_STAGE(PG8_SB(0, 0), b2, voffB); PG8_STAGE(PG8_SB(0, 1), b2 + hstep, voffB); PG8_STAGE(PG8_SA(0, 0), a2, voffA);
            PG8_WAIT_V(8); PG8_WAIT_L(0); PG8_BAR; PG8_MMA(1, 0, At, B0); PG8_MMA(1, 1, At, B1); PG8_BAR; PG8_SCHED;
            PG8_LDB(B0, 1, 0); PG8_LDB(B1, 1, 1); PG8_SCHED; PG8_LDA(At, 1, 0); PG8_STAGE(PG8_SA(0, 1), a2 + hstep, voffA);
            PG8_WAIT_V(8); PG8_WAIT_L(0); PG8_BAR; PG8_MMA(0, 0, At, B0); PG8_MMA(0, 1, At, B1); PG8_BAR; PG8_SCHED;
            PG8_LDA(At, 1, 1); PG8_STAGE(PG8_SB(1, 0), b3, voffB); PG8_STAGE(PG8_SB(1, 1), b3 + hstep, voffB); PG8_STAGE(PG8_SA(1, 0), a3, voffA);
            PG8_WAIT_V(8); PG8_WAIT_L(0); PG8_BAR; PG8_MMA(1, 0, At, B0); PG8_MMA(1, 1, At, B1); PG8_BAR; PG8_SCHED;
            } else {
            PG8_LDB(B0, 0, 0); PG8_SCHED; PG8_LDA(At, 0, 0); PG8_STAGE(PG8_SA(1, 1), a1 + hstep, voffA);
            PG8_WAIT_L(8); PG8_BAR; PG8_WAIT_L(0); PG8_MMA(0, 0, At, B0); PG8_BAR; PG8_SCHED;
            PG8_LDB(B1, 0, 1); PG8_STAGE(PG8_SB(0, 0), b2, voffB);
            PG8_BAR; PG8_WAIT_L(0); PG8_MMA(0, 1, At, B1); PG8_BAR;
            PG8_LDA(At, 0, 1); PG8_STAGE(PG8_SA(0, 0), a2, voffA);
            PG8_BAR; PG8_WAIT_L(0); PG8_MMA(1, 0, At, B0); PG8_BAR; PG8_SCHED;
            PG8_STAGE(PG8_SB(0, 1), b2 + hstep, voffB);
            PG8_WAIT_V(6); PG8_BAR; PG8_MMA(1, 1, At, B1); PG8_BAR;
            PG8_LDB(B0, 1, 0); PG8_SCHED; PG8_LDA(At, 1, 0); PG8_STAGE(PG8_SA(0, 1), a2 + hstep, voffA);
            PG8_WAIT_L(8); PG8_BAR; PG8_WAIT_L(0); PG8_MMA(0, 0, At, B0); PG8_BAR; PG8_SCHED;
            PG8_LDB(B1, 1, 1); PG8_STAGE(PG8_SB(1, 0), b3, voffB);
            PG8_BAR; PG8_WAIT_L(0); PG8_MMA(0, 1, At, B1); PG8_BAR;
            PG8_LDA(At, 1, 1); PG8_STAGE(PG8_SA(1, 0), a3, voffA);
            PG8_BAR; PG8_WAIT_L(0); PG8_MMA(1, 0, At, B0); PG8_BAR; PG8_SCHED;
            PG8_STAGE(PG8_SB(1, 1), b3 + hstep, voffB);
            PG8_WAIT_V(6); PG8_BAR; PG8_MMA(1, 1, At, B1); PG8_BAR;
            }
        }
        if constexpr (ALIGN_EPI) { if (wr == 0) PG8_BAR; }
        if constexpr (!Epi::AFTER_DRAIN) { E(acc, cur, wr, wc, fr, fq); S.done(cur); }
        if (!has_next) break;
#pragma unroll
        for (int a = 0; a < 2; ++a)
#pragma unroll
            for (int b = 0; b < 2; ++b)
#pragma unroll
                for (int m = 0; m < 4; ++m)
#pragma unroll
                    for (int n = 0; n < 2; ++n) acc[a][b][m][n] = (f32x4){0.f, 0.f, 0.f, 0.f};
        cur = nxt; cA = nA; cB = nB; ++ui;
        if constexpr (ALIGN_EPI) { if (wr == 1) PG8_BAR; }
    }
    PG8_WAIT_V(0);
    if constexpr (!ALIGN_EPI) { if (wr == 0) PG8_BAR; }
    PG8_BAR;
    if constexpr (Epi::AFTER_DRAIN) { E.fused(acc, cur, wr, wc, fr, fq, lds, wid, lane); S.done(cur); }
#undef PG8_SA
#undef PG8_SB
#undef PG8_STAGE
#undef PG8_LDA
#undef PG8_LDB
#undef PG8_MMA
#undef PG8_WAIT_V
#undef PG8_WAIT_L
#undef PG8_BAR
#undef PG8_SCHED
}
}

#define GAS __attribute__((address_space(1)))
#define LAS __attribute__((address_space(3)))
typedef unsigned short bf16;
typedef unsigned v4u __attribute__((ext_vector_type(4)));
typedef unsigned v2u __attribute__((ext_vector_type(2)));
typedef float f32x4 __attribute__((ext_vector_type(4)));
typedef float f32x2 __attribute__((ext_vector_type(2)));
typedef float f32x16 __attribute__((ext_vector_type(16)));
typedef short bf16x8 __attribute__((ext_vector_type(8)));
using pg8::cvt_pk_bf16;

constexpr int D = 1024, SEQ = 16384, NSB = 8, NST = 32, M = SEQ + NSB * NST  , INW = 1536, DFF = 2816, GUW = 2 * DFF, NMOD = 6 * D;
constexpr int NCH = M / 32;
constexpr float EPS = 1e-6f;
constexpr size_t O_PRE = (size_t)M * D, O_PIM = O_PRE + 2048, O_SRE = O_PIM + 2048, O_SIM = O_SRE + 16384, O_V = O_SIM + 16384;

constexpr size_t MiB = 1u << 20, KiB = 1u << 10;
constexpr size_t WS_MODP = 240 * MiB;
constexpr int NKS = 16;
constexpr size_t WS_MODF = 2 * MiB;
constexpr size_t WS_TB = 2 * MiB + 512 * KiB;
constexpr size_t WS_TC = WS_TB + 128 * KiB;
constexpr size_t WS_TA = WS_TC + 128 * KiB;
constexpr size_t WS_TP = WS_TA + 64 * KiB;
constexpr size_t WS_STATS = 3 * MiB;
constexpr size_t WS_WIN = 4 * MiB, WS_WGLU = 7 * MiB, WS_WOUT = 8 * MiB, WS_WGU = 10 * MiB, WS_WD = 21 * MiB;
constexpr size_t WS_SLOC = 27 * MiB, WS_SST = 35 * MiB;
constexpr size_t WS_H = 44 * MiB;
constexpr size_t WS_X1 = 77 * MiB;
constexpr size_t ACT5 = (size_t)M * 512 * 2;
constexpr size_t WS_ZS5 = 142 * MiB, WS_UG = WS_ZS5 + ACT5, WS_GV = WS_UG + ACT5, WS_YS = WS_GV + ACT5, WS_CAT = WS_YS + ACT5;
constexpr size_t WS_HID = 142 * MiB;
constexpr size_t WS_END = WS_CAT + (size_t)M * 1024 * 2;
static_assert(WS_END <= 256 * MiB && WS_HID + (size_t)M * DFF * 2 <= WS_END, "ws map");
constexpr int LDS_BYTES = 147456;
constexpr int NPH = 12;

__device__ __forceinline__ float bf2f(unsigned short b) { return __builtin_bit_cast(float, ((unsigned)b) << 16); }
__device__ __forceinline__ float bflo(unsigned w) { return __builtin_bit_cast(float, w << 16); }
__device__ __forceinline__ float bfhi(unsigned w) { return __builtin_bit_cast(float, w & 0xffff0000u); }
__device__ __forceinline__ float sigm(float x) { return __builtin_amdgcn_rcpf(1.f + __expf(-x)); }
__device__ __forceinline__ float gelu_t(float x) { const float z = 1.5957691216f * (x + 0.044715f * x * x * x); return x * sigm(z); }
__device__ __forceinline__ float silu_f(float x) { return x * sigm(x); }
__device__ __forceinline__ float wave_sum(float v) {
#pragma unroll
    for (int o = 1; o < 64; o <<= 1) v += __shfl_xor(v, o);
    return v;
}
#define LDS_WAIT() asm volatile("s_waitcnt lgkmcnt(0)" ::: "memory")

#define XB_TMO      128
#define XB_XCNT(j)  (256  + 64 * (j))
#define XB_XSUB(j)  (1280 + 64 * (j))
#define XB_XGEN(j)  (2304 + 64 * (j))
#define XB_TOP      3328
#define XB_TOPGEN   3392
#define XCD_BAR_WORDS 3456
#define XB_SPIN_CAP (1u << 18)

__device__ __forceinline__ unsigned xb_ld(unsigned* p)              { return __hip_atomic_load(p, __ATOMIC_RELAXED, __HIP_MEMORY_SCOPE_AGENT); }
__device__ __forceinline__ unsigned xb_add(unsigned* p, unsigned v) { return __hip_atomic_fetch_add(p, v, __ATOMIC_RELAXED, __HIP_MEMORY_SCOPE_AGENT); }
__device__ __forceinline__ unsigned xb_xcc_id() { return (unsigned)__builtin_amdgcn_s_getreg((3 << 11) | 20) & 0xFu; }
#define XB_SPIN(cond, bar) do { unsigned _sp = 0; while (cond) { __builtin_amdgcn_s_sleep(1); \
    if ((++_sp & 255u) == 0u) { if (xb_ld(&(bar)[XB_TMO])) break; if (_sp > XB_SPIN_CAP) { atomicAdd(&(bar)[XB_TMO], 1u); break; } } } } while (0)

struct XcdBarrier {
    unsigned* bar; unsigned x;
    volatile LAS unsigned* st;
};

__device__ __forceinline__ XcdBarrier xcd_barrier_post(unsigned* bar, volatile LAS unsigned* st) {
    XcdBarrier b; b.bar = bar; b.x = xb_xcc_id(); b.st = st;
    if (threadIdx.x == 0) (void)xb_add(&bar[XB_XCNT(b.x)], 1u);
    return b;
}
__device__ __forceinline__ void xcd_barrier_complete(unsigned* bar, unsigned x, unsigned& nloc, unsigned& nx) {
    const unsigned G = gridDim.x * gridDim.y * gridDim.z;
    unsigned sum, cnt, mine, sp = 0u;
    for (;;) {
        sum = 0u; cnt = 0u; mine = 0u;
#pragma unroll
        for (unsigned j = 0; j < 16; ++j) { const unsigned c = xb_ld(&bar[XB_XCNT(j)]); sum += c; cnt += (c > 0u) ? 1u : 0u; mine = (j == x) ? c : mine; }
        if (sum == G) break;
        __builtin_amdgcn_s_sleep(1);
        if ((++sp & 255u) == 0u) { if (xb_ld(&bar[XB_TMO])) break; if (sp > XB_SPIN_CAP) { atomicAdd(&bar[XB_TMO], 1u); break; } }
    }
    nloc = mine > 0u ? mine : 1u; nx = cnt > 0u ? cnt : 1u;
}

__device__ __forceinline__ void xcd_barrier(const XcdBarrier& b) {
    asm volatile("s_waitcnt vmcnt(0)" ::: "memory");
    __syncthreads();
    if (threadIdx.x == 0) {
        unsigned* bar = b.bar;
        __builtin_amdgcn_s_waitcnt(0);
        unsigned nloc = b.st[0], nx = b.st[1];
        if (nloc == 0u) { xcd_barrier_complete(bar, b.x, nloc, nx); b.st[0] = nloc; b.st[1] = nx; }
        const unsigned old = xb_add(&bar[XB_XSUB(b.x)], 1u);
        const unsigned gen = old / nloc;
        if (old + 1u == (gen + 1u) * nloc) {
            __builtin_amdgcn_fence(__ATOMIC_RELEASE, "agent");
            asm volatile("s_waitcnt vmcnt(0)" ::: "memory");
            const unsigned og = xb_add(&bar[XB_TOP], 1u);
            const unsigned tg = og / nx;
            if (og + 1u == (tg + 1u) * nx) xb_add(&bar[XB_TOPGEN], 1u);
            else XB_SPIN(xb_ld(&bar[XB_TOPGEN]) == tg, bar);
            __builtin_amdgcn_fence(__ATOMIC_ACQUIRE, "agent");
            xb_add(&bar[XB_XGEN(b.x)], 1u);
            asm volatile("s_waitcnt vmcnt(0)" ::: "memory");
        } else {
            XB_SPIN(xb_ld(&bar[XB_XGEN(b.x)]) == gen, bar);
            __builtin_amdgcn_fence(__ATOMIC_ACQUIRE, "agent");
            asm volatile("s_waitcnt vmcnt(0)" ::: "memory");
        }
    }
    __syncthreads();
}

struct Args { const float* in[29]; float* out; unsigned char* ws; int ph_lo, ph_hi; };

__device__ __forceinline__ void p0_transpose_item(const float* W, int K, int N, bf16* WT, int dst_row0, LAS float* scr, int kb, int nb, int lane) {
    const int k0 = 64 * kb, n0 = 32 * nb;
#pragma unroll
    for (int i = 0; i < 32; ++i) { const int kk = 2 * i + (lane >> 5); scr[kk * 33 + (lane & 31)] = W[(size_t)(k0 + kk) * N + n0 + (lane & 31)]; }
    LDS_WAIT();
    const int c = lane & 7;
#pragma unroll
    for (int j = 0; j < 4; ++j) { const int n = (lane >> 3) + 8 * j; const LAS float* s = scr + (8 * c) * 33 + n;
        v4u o; o.x = cvt_pk_bf16(s[0 * 33], s[1 * 33]); o.y = cvt_pk_bf16(s[2 * 33], s[3 * 33]); o.z = cvt_pk_bf16(s[4 * 33], s[5 * 33]); o.w = cvt_pk_bf16(s[6 * 33], s[7 * 33]);
        *(v4u*)(WT + (size_t)(dst_row0 + n) * K + k0 + 8 * c) = o; }
    LDS_WAIT();
}
__device__ __forceinline__ float rl(float v, int l) { return __builtin_bit_cast(float, __builtin_amdgcn_readlane(__builtin_bit_cast(int, v), l)); }

__device__ __forceinline__ void p0_ada_item(const Args& a, int cs, int ks, int lane) {
    const float* cp = a.in[4]; const float* csm = a.in[5]; const float* W = a.in[8];
    float* modp = (float*)(a.ws + WS_MODP);
    const int c0 = cs * 256 + 4 * lane, k0 = ks * 64;
    float sl[9];
#pragma unroll
    for (int b = 0; b < 9; ++b) { const int k = k0 + lane; const float cv = (b == 0) ? cp[k] : csm[(b - 1) * D + k]; sl[b] = silu_f(cv); }
    f32x4 acc[9];
#pragma unroll
    for (int b = 0; b < 9; ++b) acc[b] = (f32x4){0.f, 0.f, 0.f, 0.f};
#pragma unroll 16
    for (int kk = 0; kk < 64; ++kk) {
        const f32x4 w = *(const f32x4*)(W + (size_t)(k0 + kk) * NMOD + c0);
#pragma unroll
        for (int b = 0; b < 9; ++b) { const float s = rl(sl[b], kk); acc[b] += w * s; }
    }
#pragma unroll
    for (int b = 0; b < 9; ++b) *(f32x4*)(modp + ((size_t)ks * 9 + b) * NMOD + c0) = acc[b];
}

__device__ __forceinline__ void p0_s5_tables(const Args& a, int g, int lane) {
    const int n = lane;
    const float step = expf(a.in[13][g]);
    const float lr = a.in[11][g * 64 + n], li = a.in[12][g * 64 + n];
    const float x = lr * step, y = li * step;
    const float ex = expf(x), cy = cosf(y), sy = sinf(y), sh = sinf(0.5f * y);
    const float a1r = ex * cy, a1i = ex * sy;
    const float mr = expm1f(x) * cy - 2.f * sh * sh, mi = ex * sy;
    const float den = lr * lr + li * li;
    const float fr = (mr * lr + mi * li) / den, fi = (mi * lr - mr * li) / den;
    bf16* TB = (bf16*)(a.ws + WS_TB); bf16* TC = (bf16*)(a.ws + WS_TC); float* TA = (float*)(a.ws + WS_TA); float* TP = (float*)(a.ws + WS_TP);
    const float* br = a.in[14] + (size_t)(g * 64 + n) * 16; const float* bi = a.in[15] + (size_t)(g * 64 + n) * 16;
    const int xx = n >> 1, sbit = n & 1;
    bf16* rowre = TB + (size_t)(g * 128 + (0 + sbit) * 32 + xx) * 16;
    bf16* rowim = TB + (size_t)(g * 128 + (2 + sbit) * 32 + xx) * 16;
#pragma unroll
    for (int q = 0; q < 16; q += 2) {
        const float b0r = br[q], b0i = bi[q], b1r = br[q + 1], b1i = bi[q + 1];
        *(unsigned*)(rowre + q) = cvt_pk_bf16(fr * b0r - fi * b0i, fr * b1r - fi * b1i);
        *(unsigned*)(rowim + q) = cvt_pk_bf16(fr * b0i + fi * b0r, fr * b1i + fi * b1r);
    }
    double pr = a1r, pi = a1i;
    double p2r = pr * pr - pi * pi, p2i = 2.0 * pr * pi;
    double p3r = p2r * pr - p2i * pi, p3i = p2r * pi + p2i * pr;
    double p4r = p2r * p2r - p2i * p2i, p4i = 2.0 * p2r * p2i;
    float* ta = TA + (size_t)(g * 64 + n) * 8;
    ta[0] = (float)pr; ta[1] = (float)pi; ta[2] = (float)p2r; ta[3] = (float)p2i; ta[4] = (float)p3r; ta[5] = (float)p3i; ta[6] = (float)p4r; ta[7] = (float)p4i;
    double qr = p4r, qi = p4i;
#pragma unroll
    for (int s = 0; s < 3; ++s) { const double t = qr * qr - qi * qi; qi = 2.0 * qr * qi; qr = t; }
    float* tp = TP + (size_t)(g * 64 + n) * 4;
    tp[0] = (float)qr; tp[1] = (float)qi;
#pragma unroll
    for (int s = 0; s < 6; ++s) { const double t = qr * qr - qi * qi; qi = 2.0 * qr * qi; qr = t; }
    tp[2] = (float)qr; tp[3] = (float)qi;
    const float* cr = a.in[16] + (size_t)g * 16 * 64; const float* ci = a.in[17] + (size_t)g * 16 * 64;
#pragma unroll
    for (int p = 0; p < 16; ++p) { TC[(size_t)(g * 16 + p) * 128 + n] = (bf16)(cvt_pk_bf16(cr[p * 64 + n], 0.f) & 0xffffu); TC[(size_t)(g * 16 + p) * 128 + 64 + n] = (bf16)(cvt_pk_bf16(-ci[p * 64 + n], 0.f) & 0xffffu); }
}

__device__ __forceinline__ void p0_prologue(const Args& a, LAS unsigned char* lds, int vw, int NGW, int wave, int lane) {
    LAS float* scr = (LAS float*)(lds + wave * 16384);
    constexpr int I_ADA = 24 * NKS, I_S5 = 32, I_IN = 16 * 48, I_GLU = 8 * 16, I_OUT = 16 * 32, I_GU = 16 * 176, I_D = 44 * 32;
    constexpr int NITEMS = I_ADA + I_S5 + I_IN + I_GLU + I_OUT + I_GU + I_D;
    for (int it = vw; it < NITEMS; it += NGW) {
        int r = it;
        if (r < I_ADA) { p0_ada_item(a, r % 24, r / 24, lane); continue; } r -= I_ADA;
        if (r < I_S5) { p0_s5_tables(a, r, lane); continue; } r -= I_S5;
        if (r < I_IN) { const int nblk = INW / 32, kb = r / nblk, nb = r % nblk; p0_transpose_item(a.in[10], D, INW, (bf16*)(a.ws + WS_WIN), 32 * nb, scr, kb, nb, lane); continue; } r -= I_IN;
        if (r < I_GLU) { const int nblk = 16, kb = r / nblk, nb = r % nblk; p0_transpose_item(a.in[19], 512, 512, (bf16*)(a.ws + WS_WGLU), 32 * nb, scr, kb, nb, lane); continue; } r -= I_GLU;
        if (r < I_OUT) { const int nblk = 32, kb = r / nblk, nb = r % nblk; p0_transpose_item(a.in[25], D, D, (bf16*)(a.ws + WS_WOUT), 32 * nb, scr, kb, nb, lane); continue; } r -= I_OUT;
        if (r < I_GU) { const int nblk = GUW / 32, kb = r / nblk, nb = r % nblk; const int n0 = 32 * nb; const int j = n0 < DFF ? n0 : n0 - DFF;
            const int drow = 256 * (j >> 7) + (n0 < DFF ? 0 : 128) + (j & 127);
            p0_transpose_item(a.in[26], D, GUW, (bf16*)(a.ws + WS_WGU), drow, scr, kb, nb, lane); continue; } r -= I_GU;
        { const int nblk = 32, kb = r / nblk, nb = r % nblk; p0_transpose_item(a.in[27], DFF, D, (bf16*)(a.ws + WS_WD), 32 * nb, scr, kb, nb, lane); }
    }
}

template <int WHICH>
__device__ __forceinline__ void hprep(const Args& a, int vw, int NGW, int lane, LAS float* lco) {
    const float* gvec = a.in[WHICH == 0 ? 6 : 7];
    const float* modp = (const float*)(a.ws + WS_MODP); const float* modf = (const float*)(a.ws + WS_MODF); const float* bada = a.in[9];
    bf16* H = (bf16*)(a.ws + WS_H);
    const int soff = WHICH == 0 ? 0 : 3 * D, coff = soff + D;
    int cur = -1; f32x4 ca[4], cb[4];
    constexpr int NB = 4;
    for (int mb = vw; mb < M; mb += NB * NGW) {
        f32x4 v[NB][4];
#pragma unroll
        for (int b = 0; b < NB; ++b) { const int m = mb + b * NGW;
            if (m < M) { const float* xrow = WHICH == 0 ? (m < SEQ ? a.in[0] + (size_t)m * D : a.in[1] + (size_t)(m - SEQ) * D) : (const float*)(a.ws + WS_X1) + (size_t)m * D;
#pragma unroll
                for (int j = 0; j < 4; ++j) v[b][j] = *(const f32x4*)(xrow + 4 * lane + 256 * j); } }
#pragma unroll
        for (int b = 0; b < NB; ++b) { const int m = mb + b * NGW;
            if (m < M) {
                const int mr = m < SEQ ? 0 : 1 + ((m - SEQ) >> 5);
                if (mr != cur) { cur = mr;
#pragma unroll
                    for (int j = 0; j < 4; ++j) { const int k = 4 * lane + 256 * j; f32x4 sc, sh;
                        if (WHICH == 0 && mr == 0) { sc = *(const LAS f32x4*)(lco + k); sh = *(const LAS f32x4*)(lco + D + k); }
                        else if (WHICH == 0) { sc = *(const f32x4*)(bada + coff + k); sh = *(const f32x4*)(bada + soff + k);
#pragma unroll
                            for (int ks = 0; ks < NKS; ++ks) { sc += *(const f32x4*)(modp + ((size_t)ks * 9 + mr) * NMOD + coff + k); sh += *(const f32x4*)(modp + ((size_t)ks * 9 + mr) * NMOD + soff + k); } }
                        else { sc = *(const f32x4*)(modf + (size_t)mr * NMOD + coff + k); sh = *(const f32x4*)(modf + (size_t)mr * NMOD + soff + k); }
                        const f32x4 gg = *(const f32x4*)(gvec + k); ca[j] = gg * (sc + 1.0f); cb[j] = sh; } }
                float ss = 0.f;
#pragma unroll
                for (int j = 0; j < 4; ++j) ss += (v[b][j].x * v[b][j].x + v[b][j].y * v[b][j].y) + (v[b][j].z * v[b][j].z + v[b][j].w * v[b][j].w);
                const float rstd = 1.0f / sqrtf(wave_sum(ss) * (1.0f / D) + EPS);
#pragma unroll
                for (int j = 0; j < 4; ++j) { const f32x4 o = v[b][j] * rstd * ca[j] + cb[j]; v2u w; w.x = cvt_pk_bf16(o.x, o.y); w.y = cvt_pk_bf16(o.z, o.w);
                    *(v2u*)(H + (size_t)m * D + 4 * lane + 256 * j) = w; }
            } }
    }
}

using pg8::Unit;
struct EpiIn {
    static constexpr bool PERM = true, AFTER_DRAIN = false;
    bf16 *zs5, *ug, *gv;
    __device__ __forceinline__ void operator()(const f32x4 (&acc)[2][2][4][2], const Unit& u, int wr, int wc, int fr, int fq) const {
        const int sec = u.pn >> 1; bf16* base = zs5 + (size_t)sec * (ACT5 / 2);
        const int row0 = u.pm * 256 + wr * 64 + fr, col0 = (u.pn & 1) * 256 + wc * 32 + 8 * fq;
#pragma unroll
        for (int ai = 0; ai < 2; ++ai)
#pragma unroll
            for (int m = 0; m < 4; ++m) { bf16* rowp = base + (size_t)(row0 + ai * 128 + m * 16) * 512 + col0;
#pragma unroll
                for (int bj = 0; bj < 2; ++bj) { const f32x4 v0 = acc[ai][bj][m][0], v1 = acc[ai][bj][m][1];
                    v4u w;
                    if (sec) { w.x = cvt_pk_bf16(gelu_t(v0.x), gelu_t(v0.y)); w.y = cvt_pk_bf16(gelu_t(v0.z), gelu_t(v0.w)); w.z = cvt_pk_bf16(gelu_t(v1.x), gelu_t(v1.y)); w.w = cvt_pk_bf16(gelu_t(v1.z), gelu_t(v1.w)); }
                    else { w.x = cvt_pk_bf16(v0.x, v0.y); w.y = cvt_pk_bf16(v0.z, v0.w); w.z = cvt_pk_bf16(v1.x, v1.y); w.w = cvt_pk_bf16(v1.z, v1.w); }
                    *(v4u*)(rowp + bj * 128) = w; }
                asm volatile("" ::: "memory"); }
    }
};
struct EpiGlu {
    static constexpr bool PERM = true, AFTER_DRAIN = false;
    const bf16* ys; bf16* cat; const float* bias;
    __device__ __forceinline__ void operator()(const f32x4 (&acc)[2][2][4][2], const Unit& u, int wr, int wc, int fr, int fq) const {
        const int row0 = u.pm * 256 + wr * 64 + fr, col0 = u.pn * 256 + wc * 32 + 8 * fq;
        f32x4 bv[2][2];
#pragma unroll
        for (int bj = 0; bj < 2; ++bj)
#pragma unroll
            for (int n = 0; n < 2; ++n) bv[bj][n] = *(const f32x4*)(bias + col0 + bj * 128 + 4 * n);
#pragma unroll
        for (int ai = 0; ai < 2; ++ai)
#pragma unroll
            for (int m = 0; m < 4; ++m) { const size_t r = (size_t)(row0 + ai * 128 + m * 16);
#pragma unroll
                for (int bj = 0; bj < 2; ++bj) { const f32x4 g0 = acc[ai][bj][m][0] + bv[bj][0], g1 = acc[ai][bj][m][1] + bv[bj][1];
                    const v4u y = *(const v4u*)(ys + r * 512 + col0 + bj * 128);
                    v4u w;
                    w.x = cvt_pk_bf16(bflo(y.x) * sigm(g0[0]), bfhi(y.x) * sigm(g0[1])); w.y = cvt_pk_bf16(bflo(y.y) * sigm(g0[2]), bfhi(y.y) * sigm(g0[3]));
                    w.z = cvt_pk_bf16(bflo(y.z) * sigm(g1[0]), bfhi(y.z) * sigm(g1[1])); w.w = cvt_pk_bf16(bflo(y.w) * sigm(g1[2]), bfhi(y.w) * sigm(g1[3]));
                    *(v4u*)(cat + r * 1024 + col0 + bj * 128) = w; } }
    }
};
struct EpiRes {
    static constexpr bool PERM = false, AFTER_DRAIN = false;
    const float* bp; const float* bs; const float* gate  ; float* out;
    __device__ __forceinline__ void operator()(const f32x4 (&acc)[2][2][4][2], const Unit& u, int wr, int wc, int fr, int fq) const {
        const int col0 = u.pn * 256 + wc * 32 + 4 * fq;
#pragma unroll
        for (int ai = 0; ai < 2; ++ai)
#pragma unroll
            for (int m = 0; m < 4; ++m) { const int rl_ = ai * 128 + wr * 64 + m * 16 + fr; const int row = u.pm * 256 + rl_;
                const float* brow = row < SEQ ? bp + (size_t)row * D : bs + (size_t)(row - SEQ) * D;
                const int mr = row < SEQ ? 0 : 1 + ((row - SEQ) >> 5);
                const float* grow = gate + (size_t)mr * NMOD;
#pragma unroll
                for (int bj = 0; bj < 2; ++bj)
#pragma unroll
                    for (int n = 0; n < 2; ++n) { const int c = col0 + bj * 128 + n * 16;
                        const f32x4 b = *(const f32x4*)(brow + c), g = *(const f32x4*)(grow + c);
                        *(f32x4*)(out + (size_t)row * D + c) = b + g * acc[ai][bj][m][n]; }
                asm volatile("" ::: "memory"); }
    }
};
struct EpiGU {
    static constexpr bool PERM = true, AFTER_DRAIN = false;
    bf16* hid;
    __device__ __forceinline__ void operator()(const f32x4 (&acc)[2][2][4][2], const Unit& u, int wr, int wc, int fr, int fq) const {
        const int row0 = u.pm * 256 + wr * 64 + fr, col0 = u.pn * 128 + wc * 32 + 8 * fq;
#pragma unroll
        for (int ai = 0; ai < 2; ++ai)
#pragma unroll
            for (int m = 0; m < 4; ++m) { bf16* rowp = hid + (size_t)(row0 + ai * 128 + m * 16) * DFF + col0;
                const f32x4 g0 = acc[ai][0][m][0], g1 = acc[ai][0][m][1], u0 = acc[ai][1][m][0], u1 = acc[ai][1][m][1];
                v4u w; w.x = cvt_pk_bf16(silu_f(g0[0]) * u0[0], silu_f(g0[1]) * u0[1]); w.y = cvt_pk_bf16(silu_f(g0[2]) * u0[2], silu_f(g0[3]) * u0[3]);
                w.z = cvt_pk_bf16(silu_f(g1[0]) * u1[0], silu_f(g1[1]) * u1[1]); w.w = cvt_pk_bf16(silu_f(g1[2]) * u1[2], silu_f(g1[3]) * u1[3]);
                *(v4u*)rowp = w; }
    }
};

#define MFMA32(a, b, c) __builtin_amdgcn_mfma_f32_32x32x16_bf16((a), (b), (c), 0, 0, 0)
#define MFMA16(a, b, c) __builtin_amdgcn_mfma_f32_16x16x32_bf16((a), (b), (c), 0, 0, 0)
template <bool FULL>
__device__ __forceinline__ void s5_phase(const Args& a, LAS unsigned char* sbuf, int vw, int NGW, int lane, int nitems) {
    const int half = lane >> 5, x = lane & 31, l15 = lane & 15, q4 = lane >> 4;
    const bf16* ZS5 = (const bf16*)(a.ws + WS_ZS5);
    const bf16* TB = (const bf16*)(a.ws + WS_TB); const float* TA = (const float*)(a.ws + WS_TA); const bf16* TC = (const bf16*)(a.ws + WS_TC);
    bf16* YS = (bf16*)(a.ws + WS_YS);
    int curg = -1;
    bf16x8 tb[4], tc[4]; f32x4 ta[2][2]; f32x4 dd;
    int it = vw; if (it >= nitems) return;
    bf16x8 un = *(const bf16x8*)(ZS5 + (size_t)((it >> 5) * 32 + x) * 512 + (it & 31) * 16 + half * 8);
    for (; it < nitems; it += NGW) {
        const int g = it & 31, ch = it >> 5, m0 = ch * 32;
        if (g != curg) { curg = g;
#pragma unroll
            for (int c = 0; c < 4; ++c) tb[c] = *(const bf16x8*)(TB + (size_t)(g * 128 + c * 32 + x) * 16 + half * 8);
#pragma unroll
            for (int s = 0; s < 2; ++s) { ta[s][0] = *(const f32x4*)(TA + (size_t)(g * 64 + 2 * x + s) * 8); ta[s][1] = *(const f32x4*)(TA + (size_t)(g * 64 + 2 * x + s) * 8 + 4); }
            if (FULL) {
#pragma unroll
                for (int ks = 0; ks < 4; ++ks) tc[ks] = *(const bf16x8*)(TC + (size_t)(g * 16 + l15) * 128 + ks * 32 + q4 * 8);
                dd = *(const f32x4*)(a.in[18] + g * 16 + q4 * 4); }
        }
        const bf16x8 ua = un;
        { const int nx = it + NGW; if (nx < nitems) un = *(const bf16x8*)(ZS5 + (size_t)((nx >> 5) * 32 + x) * 512 + (nx & 31) * 16 + half * 8); }
        float cin0r = 0.f, cin0i = 0.f, cin1r = 0.f, cin1i = 0.f;
        if (FULL) {
            if (ch >= 512) { const int b = ch - 512; const f32x2 r2 = *(const f32x2*)(a.in[2] + (size_t)(b * 32 + g) * 64 + 2 * x), i2 = *(const f32x2*)(a.in[3] + (size_t)(b * 32 + g) * 64 + 2 * x);
                cin0r = r2.x; cin1r = r2.y; cin0i = i2.x; cin1i = i2.y; }
            else if (ch > 0) { const float* sst = (const float*)(a.ws + WS_SST) + (size_t)(ch * 32 + g) * 128; const f32x2 r2 = *(const f32x2*)(sst + 2 * x), i2 = *(const f32x2*)(sst + 64 + 2 * x);
                cin0r = r2.x; cin1r = r2.y; cin0i = i2.x; cin1i = i2.y; }
        }
        v2u uu[2];
        if (FULL) {
#pragma unroll
            for (int tt = 0; tt < 2; ++tt) uu[tt] = *(const v2u*)(ZS5 + (size_t)(m0 + tt * 16 + l15) * 512 + g * 16 + q4 * 4); }
        f32x16 acc[4];
#pragma unroll
        for (int c = 0; c < 4; ++c) { f32x16 z;
#pragma unroll
            for (int r = 0; r < 16; ++r) z[r] = 0.f;
            acc[c] = MFMA32(ua, tb[c], z); }
        float endr[2], endi[2];
#pragma unroll
        for (int s = 0; s < 2; ++s) {
            const f32x4 t0 = ta[s][0], t1 = ta[s][1];
            const float apr[4] = {t0.x, t0.z, t1.x, t1.z}, api[4] = {t0.y, t0.w, t1.y, t1.w};
            const float a1r = apr[0], a1i = api[0], a4r = apr[3], a4i = api[3];
            f32x16& R = acc[s]; f32x16& I = acc[2 + s];
#pragma unroll
            for (int i = 0; i < 4; ++i)
#pragma unroll
                for (int j = 1; j < 4; ++j) { const int r = 4 * i + j; const float pr = R[r - 1], pi = I[r - 1];
                    R[r] += a1r * pr - a1i * pi; I[r] += a1r * pi + a1i * pr; }
            float cr = s ? cin1r : cin0r, ci = s ? cin1i : cin0i;
            float cinr[4], cini[4];
#pragma unroll
            for (int i = 0; i < 4; ++i) {
                const float lr_ = R[4 * i + 3], li_ = I[4 * i + 3];
                const float candr = a4r * cr - a4i * ci + lr_, candi = a4r * ci + a4i * cr + li_;
                const float othr = __shfl_xor(candr, 32), othi = __shfl_xor(candi, 32);
                cinr[i] = half ? othr : cr; cini[i] = half ? othi : ci;
                const float outr = a4r * cinr[i] - a4i * cini[i] + lr_, outi = a4r * cini[i] + a4i * cinr[i] + li_;
                cr = __shfl_xor(outr, 32); ci = __shfl_xor(outi, 32);
            }
            endr[s] = cr; endi[s] = ci;
            if (FULL) {
#pragma unroll
                for (int i = 0; i < 4; ++i)
#pragma unroll
                    for (int j = 0; j < 4; ++j) { const int r = 4 * i + j;
                        R[r] += apr[j] * cinr[i] - api[j] * cini[i]; I[r] += apr[j] * cini[i] + api[j] * cinr[i]; }
            }
        }
        if (!FULL) {
            if (half == 0) { float* sl = (float*)(a.ws + WS_SLOC) + (size_t)(ch * 32 + g) * 128;
                *(f32x2*)(sl + 2 * x) = (f32x2){endr[0], endr[1]}; *(f32x2*)(sl + 64 + 2 * x) = (f32x2){endi[0], endi[1]}; }
            continue;
        }
        if (half == 0 && ch >= 511) {
            float* ore = ch == 511 ? a.out + O_PRE + g * 64 : a.out + O_SRE + (size_t)((ch - 512) * 32 + g) * 64;
            float* oim = ch == 511 ? a.out + O_PIM + g * 64 : a.out + O_SIM + (size_t)((ch - 512) * 32 + g) * 64;
            *(f32x2*)(ore + 2 * x) = (f32x2){endr[0], endr[1]}; *(f32x2*)(oim + 2 * x) = (f32x2){endi[0], endi[1]};
        }
#pragma unroll
        for (int r = 0; r < 16; ++r) { const int t = (r & 3) + 8 * (r >> 2) + 4 * half;
            *(LAS unsigned*)(sbuf + t * 272 + 4 * x) = cvt_pk_bf16(acc[0][r], acc[1][r]);
            *(LAS unsigned*)(sbuf + t * 272 + 128 + 4 * x) = cvt_pk_bf16(acc[2][r], acc[3][r]); }
        LDS_WAIT();
        f32x4 y[2] = {(f32x4){0.f, 0.f, 0.f, 0.f}, (f32x4){0.f, 0.f, 0.f, 0.f}};
#pragma unroll
        for (int ks = 0; ks < 4; ++ks) {
#pragma unroll
            for (int tt = 0; tt < 2; ++tt) { const bf16x8 sb = *(const LAS bf16x8*)(sbuf + (tt * 16 + l15) * 272 + (ks * 32 + q4 * 8) * 2); y[tt] = MFMA16(tc[ks], sb, y[tt]); } }
        LDS_WAIT();
#pragma unroll
        for (int tt = 0; tt < 2; ++tt) { const size_t off = (size_t)(m0 + tt * 16 + l15) * 512 + g * 16 + q4 * 4;
            const float o0 = gelu_t(y[tt][0] + dd[0] * bflo(uu[tt].x)), o1 = gelu_t(y[tt][1] + dd[1] * bfhi(uu[tt].x)), o2 = gelu_t(y[tt][2] + dd[2] * bflo(uu[tt].y)), o3 = gelu_t(y[tt][3] + dd[3] * bfhi(uu[tt].y));
            v2u w; w.x = cvt_pk_bf16(o0, o1); w.y = cvt_pk_bf16(o2, o3); *(v2u*)(YS + off) = w; }
    }
}

__device__ __forceinline__ void s5_chunk_scan(const Args& a, int g, LAS unsigned char* lds, int tid) {
    const int n = tid & 63, seg = tid >> 6;
    const float* TP = (const float*)(a.ws + WS_TP) + (size_t)(g * 64 + n) * 4;
    const float pr = TP[0], pi = TP[1], qr = TP[2], qi = TP[3];
    const float* sl = (const float*)(a.ws + WS_SLOC) + (size_t)(seg * 64) * 4096 + g * 128 + n;
    float* st = (float*)(a.ws + WS_SST) + (size_t)(seg * 64) * 4096 + g * 128 + n;
    float vr = 0.f, vi = 0.f;
    for (int hb = 0; hb < 2; ++hb) {
        float lre[32], lim[32];
        const float* sp = sl + (size_t)hb * 32 * 4096;
#pragma unroll
        for (int k = 0; k < 32; ++k) { lre[k] = sp[(size_t)k * 4096]; lim[k] = sp[(size_t)k * 4096 + 64]; }
#pragma unroll
        for (int k = 0; k < 32; ++k) { const float t = pr * vr - pi * vi + lre[k]; vi = pr * vi + pi * vr + lim[k]; vr = t; }
    }
    LAS f32x2* agg = (LAS f32x2*)lds;
    agg[seg * 64 + n] = (f32x2){vr, vi};
    __syncthreads();
    float cr = 0.f, ci = 0.f;
    for (int s = 0; s < seg; ++s) { const f32x2 ag = agg[s * 64 + n]; const float t = qr * cr - qi * ci + ag.x; ci = qr * ci + qi * cr + ag.y; cr = t; }
    vr = cr; vi = ci;
    for (int hb = 0; hb < 2; ++hb) {
        float lre[32], lim[32];
        const float* sp = sl + (size_t)hb * 32 * 4096; float* dp = st + (size_t)hb * 32 * 4096;
#pragma unroll
        for (int k = 0; k < 32; ++k) { lre[k] = sp[(size_t)k * 4096]; lim[k] = sp[(size_t)k * 4096 + 64]; }
#pragma unroll
        for (int k = 0; k < 32; ++k) { dp[(size_t)k * 4096] = vr; dp[(size_t)k * 4096 + 64] = vi;
            const float t = pr * vr - pi * vi + lre[k]; vi = pr * vi + pi * vr + lim[k]; vr = t; }
    }
    __syncthreads();
}

__device__ __forceinline__ void ln_stats(const Args& a, int vw, int NGW, int lane) {
    const bf16* GV = (const bf16*)(a.ws + WS_GV); f32x2* ST = (f32x2*)(a.ws + WS_STATS);
    constexpr int NB = 8;
    for (int mb = vw; mb < M; mb += NB * NGW) {
        v4u rw[NB];
#pragma unroll
        for (int b = 0; b < NB; ++b) { const int m = mb + b * NGW; if (m < M) rw[b] = *(const v4u*)(GV + (size_t)m * 512 + 8 * lane); }
#pragma unroll
        for (int b = 0; b < NB; ++b) { const int m = mb + b * NGW;
            if (m < M) { const unsigned wv[4] = {rw[b].x, rw[b].y, rw[b].z, rw[b].w};
                float s = 0.f, q = 0.f;
#pragma unroll
                for (int e = 0; e < 4; ++e) { const float d0 = bflo(wv[e]), d1 = bfhi(wv[e]); s += d0 + d1; q += d0 * d0 + d1 * d1; }
                s = wave_sum(s); q = wave_sum(q);
                const float mean = s * (1.0f / 512.0f), rstd = 1.0f / sqrtf(fmaxf(q * (1.0f / 512.0f) - mean * mean, 0.f) + EPS);
                if (lane == 0) ST[m] = (f32x2){mean, rstd}; } }
    }
}
template <int NKS>
__device__ __forceinline__ void gmlp_tile(const float* W, const float* BS, LAS unsigned char* vt, const bf16* UG, bf16* CAT, int m0, int h, int itile, int lane) {
    constexpr int VP = 272;
    const int half = lane >> 5, x = lane & 31, i = 32 * itile + x;
    bf16x8 bfr[NKS];
#pragma unroll
    for (int ks = 0; ks < NKS; ++ks) { const float* wp = W + (size_t)i * 128 + 16 * ks + 8 * half;
        const f32x4 w0 = *(const f32x4*)wp, w1 = *(const f32x4*)(wp + 4);
        v4u wb; wb.x = cvt_pk_bf16(w0.x, w0.y); wb.y = cvt_pk_bf16(w0.z, w0.w); wb.z = cvt_pk_bf16(w1.x, w1.y); wb.w = cvt_pk_bf16(w1.z, w1.w);
        bfr[ks] = __builtin_bit_cast(bf16x8, wb); }
    const float bsv = BS[i];
    v2u uu[2][4];
#pragma unroll
    for (int ct = 0; ct < 2; ++ct)
#pragma unroll
        for (int rq = 0; rq < 4; ++rq) uu[ct][rq] = *(const v2u*)(UG + (size_t)(m0 + i) * 512 + h * 64 + 32 * ct + 8 * rq + 4 * half);
    f32x16 acc[2];
#pragma unroll
    for (int r = 0; r < 16; ++r) { acc[0][r] = 0.f; acc[1][r] = 0.f; }
#pragma unroll
    for (int ks = 0; ks < NKS; ++ks)
#pragma unroll
        for (int ct = 0; ct < 2; ++ct) { const bf16x8 af = *(const LAS bf16x8*)(vt + (32 * ct + x) * VP + (16 * ks + 8 * half) * 2); acc[ct] = MFMA32(af, bfr[ks], acc[ct]); }
#pragma unroll
    for (int ct = 0; ct < 2; ++ct)
#pragma unroll
        for (int rq = 0; rq < 4; ++rq) { const int c0 = h * 64 + 32 * ct + 8 * rq + 4 * half; const v2u u2 = uu[ct][rq];
            const float o0 = bflo(u2.x) * (acc[ct][4 * rq + 0] + bsv), o1 = bfhi(u2.x) * (acc[ct][4 * rq + 1] + bsv), o2 = bflo(u2.y) * (acc[ct][4 * rq + 2] + bsv), o3 = bfhi(u2.y) * (acc[ct][4 * rq + 3] + bsv);
            v2u w; w.x = cvt_pk_bf16(o0, o1); w.y = cvt_pk_bf16(o2, o3);
            *(v2u*)(CAT + (size_t)(m0 + i) * 1024 + 512 + c0) = w; }
}
__device__ __forceinline__ void gmlp_item(const Args& a, int ck, int h, LAS unsigned char* vt, int lane) {
    constexpr int VP = 272;
    const int m0 = ck < 128 ? ck * 128 : SEQ + (ck - 128) * 32, ntok = ck < 128 ? 128 : 32;
    const bf16* GV = (const bf16*)(a.ws + WS_GV); const bf16* UG = (const bf16*)(a.ws + WS_UG); bf16* CAT = (bf16*)(a.ws + WS_CAT);
    const f32x2* ST = (const f32x2*)(a.ws + WS_STATS);
    const float* lg = a.in[21] + h * 64; const float* lb = a.in[22] + h * 64;
#pragma unroll
    for (int tp = 0; tp < 2; ++tp) { const int tk = lane + 64 * tp;
        if (tk < ntok) {
            const f32x2 st = ST[m0 + tk]; const float mean = st.x, rstd = st.y;
            const bf16* src = GV + (size_t)(m0 + tk) * 512 + h * 64;
            float* vout = (ck >= 128) ? a.out + O_V + (size_t)((ck - 128) * 32 + tk) * 512 + h * 64 : nullptr;
            v4u rw[8];
#pragma unroll
            for (int i = 0; i < 8; ++i) rw[i] = *(const v4u*)(src + 8 * i);
#pragma unroll
            for (int i = 0; i < 8; ++i) { const unsigned wv[4] = {rw[i].x, rw[i].y, rw[i].z, rw[i].w};
                const f32x4 g0 = *(const f32x4*)(lg + 8 * i), g1 = *(const f32x4*)(lg + 8 * i + 4), b0 = *(const f32x4*)(lb + 8 * i), b1 = *(const f32x4*)(lb + 8 * i + 4);
                const float gq[8] = {g0.x, g0.y, g0.z, g0.w, g1.x, g1.y, g1.z, g1.w}, bq[8] = {b0.x, b0.y, b0.z, b0.w, b1.x, b1.y, b1.z, b1.w};
                float vv[8];
#pragma unroll
                for (int e = 0; e < 4; ++e) { vv[2 * e] = (bflo(wv[e]) - mean) * rstd * gq[2 * e] + bq[2 * e]; vv[2 * e + 1] = (bfhi(wv[e]) - mean) * rstd * gq[2 * e + 1] + bq[2 * e + 1]; }
                if (vout) { *(f32x4*)(vout + 8 * i) = (f32x4){vv[0], vv[1], vv[2], vv[3]}; *(f32x4*)(vout + 8 * i + 4) = (f32x4){vv[4], vv[5], vv[6], vv[7]}; }
#pragma unroll
                for (int e = 0; e < 8; ++e) *(LAS unsigned short*)(vt + (8 * i + e) * VP + tk * 2) = (unsigned short)(cvt_pk_bf16(vv[e], 0.f) & 0xffffu);
            }
        }
    }
    LDS_WAIT();
    const float* W = a.in[23] + (size_t)h * 128 * 128; const float* BS = a.in[24] + h * 128;
    if (ntok == 128) {
        gmlp_tile<4>(W, BS, vt, UG, CAT, m0, h, 0, lane); gmlp_tile<4>(W, BS, vt, UG, CAT, m0, h, 1, lane);
        gmlp_tile<8>(W, BS, vt, UG, CAT, m0, h, 2, lane); gmlp_tile<8>(W, BS, vt, UG, CAT, m0, h, 3, lane);
    } else gmlp_tile<2>(W, BS, vt, UG, CAT, m0, h, 0, lane);
    LDS_WAIT();
}

__device__ __forceinline__ void skinny_sample(const bf16* A, const bf16* WT, int K, const float* base, const float* gate, float* out, int unit, int wave, int lane) {
    const int rh = unit >> 6, cs = unit & 63, l15 = lane & 15, q4 = lane >> 4;
    const int row = rh * 128 + wave * 16 + l15, c0 = cs * 16;
    const bf16* ap = A + (size_t)row * K + q4 * 8; const bf16* bp = WT + (size_t)(c0 + l15) * K + q4 * 8;
    f32x4 acc0 = (f32x4){0.f, 0.f, 0.f, 0.f}, acc1 = acc0;
#pragma unroll 4
    for (int k = 0; k < K; k += 64) {
        const bf16x8 a0 = *(const bf16x8*)(ap + k), b0 = *(const bf16x8*)(bp + k), a1 = *(const bf16x8*)(ap + k + 32), b1 = *(const bf16x8*)(bp + k + 32);
        acc0 = MFMA16(b0, a0, acc0); acc1 = MFMA16(b1, a1, acc1); }
    const f32x4 acc = acc0 + acc1;
    const int mr = 1 + (row >> 5), c = c0 + q4 * 4;
    const f32x4 b = *(const f32x4*)(base + (size_t)row * D + c), g = *(const f32x4*)(gate + (size_t)mr * NMOD + c);
    *(f32x4*)(out + (size_t)row * D + c) = b + g * acc;
}

__global__ void __launch_bounds__(512, 2) mega(Args a) {
    extern __shared__ __attribute__((aligned(16))) unsigned char lds_raw[];
    LAS unsigned char* lds = (LAS unsigned char*)lds_raw;
    cg::grid_group grid = cg::this_grid();
    const int tid = threadIdx.x, lane = tid & 63, wave = __builtin_amdgcn_readfirstlane(tid >> 6);
    const int G = gridDim.x, bx = blockIdx.x;
    const int vw = wave * G + bx, NGW = G * 8;
    const int lo = a.ph_lo, hi = a.ph_hi;
    volatile LAS unsigned* xst = (volatile LAS unsigned*)(lds + LDS_BYTES - 64);
    if (tid < 16) xst[tid] = 0u;
    __syncthreads();
    const XcdBarrier xbar = xcd_barrier_post((unsigned*)a.ws, xst);
    if (hi > 1000) grid.sync();
#ifndef REPMASK
#define REPMASK 0
#endif
#ifndef PHMASK
#define PHMASK 0xfff
#endif
#define IN(k) ((((PHMASK) >> (k)) & 1) && lo <= (k) && (k) < hi)
#define SEAM(k) do { if (IN(k) && IN((k) + 1)) xcd_barrier(xbar); } while (0)

    if (IN(0)) for (int rep = 0; rep <= ((REPMASK >> 0) & 1); ++rep) { if (rep) xcd_barrier(xbar); p0_prologue(a, lds, vw, NGW, wave, lane); }
    SEAM(0);
    if (IN(1)) for (int rep = 0; rep <= ((REPMASK >> 1) & 1); ++rep) { if (rep) xcd_barrier(xbar);
        float* modf = (float*)(a.ws + WS_MODF); const float* modp = (const float*)(a.ws + WS_MODP);
        for (int i = bx * 512 + tid; i < 9 * NMOD; i += G * 512) { float s = a.in[9][i % NMOD];
#pragma unroll
            for (int ks = 0; ks < NKS; ++ks) s += modp[(size_t)ks * 9 * NMOD + i];
            modf[i] = s; }
        { LAS float* lco = (LAS float*)lds;
            for (int k = tid; k < 2 * D; k += 512) { const int off = k < D ? D + k : k - D;
                float sv = a.in[9][off];
#pragma unroll
                for (int ks = 0; ks < NKS; ++ks) sv += modp[(size_t)ks * 9 * NMOD + off];
                lco[k] = sv; }
            __syncthreads();
            hprep<0>(a, vw, NGW, lane, lco); __syncthreads(); }
    }
    SEAM(1);
    if (IN(2)) for (int rep = 0; rep <= ((REPMASK >> 2) & 1); ++rep) { if (rep) xcd_barrier(xbar);
        pg8::Gemm g{(const bf16*)(a.ws + WS_H), (const bf16*)(a.ws + WS_WIN), M, INW, D}; pg8::StaticOrder S; S.init(M, INW, G, bx);
        EpiIn E{(bf16*)(a.ws + WS_ZS5), (bf16*)(a.ws + WS_UG), (bf16*)(a.ws + WS_GV)};
        pg8::gemm_phase<EpiIn, pg8::StaticOrder, true, true>(lds, g, S, E);
    }
    SEAM(2);
    if (IN(3)) for (int rep = 0; rep <= ((REPMASK >> 3) & 1); ++rep) { if (rep) xcd_barrier(xbar);
        ln_stats(a, vw, NGW, lane);
        s5_phase<false>(a, lds + wave * 8704, vw, NGW, lane, 512 * 32);
    }
    SEAM(3);
    if (IN(4)) for (int rep = 0; rep <= ((REPMASK >> 4) & 1); ++rep) { if (rep) xcd_barrier(xbar);
        for (int g = bx; g < 32; g += G) s5_chunk_scan(a, g, lds, tid);
        { const int gb = G > 64 ? 32 : 0; if (bx >= gb) for (int it = wave * (G - gb) + (bx - gb); it < 136 * 8; it += (G - gb) * 8) gmlp_item(a, it >> 3, it & 7, lds + wave * 17408, lane); }
    }
    SEAM(4);
    if (IN(5)) for (int rep = 0; rep <= ((REPMASK >> 5) & 1); ++rep) { if (rep) xcd_barrier(xbar);
        s5_phase<true>(a, lds + wave * 8704, vw, NGW, lane, NCH * 32);
    }
    SEAM(5);
    if (IN(6)) for (int rep = 0; rep <= ((REPMASK >> 6) & 1); ++rep) { if (rep) xcd_barrier(xbar);
        pg8::Gemm g{(const bf16*)(a.ws + WS_YS), (const bf16*)(a.ws + WS_WGLU), M, 512, 512}; pg8::StaticOrder S; S.init(M, 512, G, bx);
        EpiGlu E{(const bf16*)(a.ws + WS_YS), (bf16*)(a.ws + WS_CAT), a.in[20]};
        pg8::gemm_phase<EpiGlu, pg8::StaticOrder, true, true>(lds, g, S, E);
    }
    SEAM(6);
    if (IN(7)) for (int rep = 0; rep <= ((REPMASK >> 7) & 1); ++rep) { if (rep) xcd_barrier(xbar);
        pg8::Gemm g{(const bf16*)(a.ws + WS_CAT), (const bf16*)(a.ws + WS_WOUT), SEQ, D, D}; pg8::StaticOrder S; S.init(SEQ, D, G, bx);
        EpiRes E{a.in[0], a.in[1], (const float*)(a.ws + WS_MODF) + 2 * D, (float*)(a.ws + WS_X1)};
        pg8::gemm_phase<EpiRes, pg8::StaticOrder, true, true>(lds, g, S, E);
        for (int u = bx; u < 128; u += G) skinny_sample((const bf16*)(a.ws + WS_CAT) + (size_t)SEQ * D, (const bf16*)(a.ws + WS_WOUT), D, a.in[1], (const float*)(a.ws + WS_MODF) + 2 * D, (float*)(a.ws + WS_X1) + (size_t)SEQ * D, u, wave, lane);
    }
    SEAM(7);
    if (IN(8)) for (int rep = 0; rep <= ((REPMASK >> 8) & 1); ++rep) { if (rep) xcd_barrier(xbar); hprep<1>(a, vw, NGW, lane, (LAS float*)lds); }
    SEAM(8);
    if (IN(9)) for (int rep = 0; rep <= ((REPMASK >> 9) & 1); ++rep) { if (rep) xcd_barrier(xbar);
        pg8::Gemm g{(const bf16*)(a.ws + WS_H), (const bf16*)(a.ws + WS_WGU), M, GUW, D}; pg8::StaticOrder S; S.init(M, GUW, G, bx);
        EpiGU E{(bf16*)(a.ws + WS_HID)};
        pg8::gemm_phase<EpiGU, pg8::StaticOrder, true, true>(lds, g, S, E);
    }
    SEAM(9);
    if (IN(10)) for (int rep = 0; rep <= ((REPMASK >> 10) & 1); ++rep) { if (rep) xcd_barrier(xbar);
        pg8::Gemm g{(const bf16*)(a.ws + WS_HID), (const bf16*)(a.ws + WS_WD), SEQ, D, DFF}; pg8::StaticOrder S; S.init(SEQ, D, G, bx);
        const float* x1 = (const float*)(a.ws + WS_X1);
        EpiRes E{x1, x1 + (size_t)SEQ * D, (const float*)(a.ws + WS_MODF) + 5 * D, a.out};
        pg8::gemm_phase<EpiRes, pg8::StaticOrder, true, true>(lds, g, S, E);
        for (int u = bx; u < 128; u += G) skinny_sample((const bf16*)(a.ws + WS_HID) + (size_t)SEQ * DFF, (const bf16*)(a.ws + WS_WD), DFF, x1 + (size_t)SEQ * D, (const float*)(a.ws + WS_MODF) + 5 * D, a.out + (size_t)SEQ * D, u, wave, lane);
    }
    SEAM(10);
    if (IN(11)) for (int rep = 0; rep <= ((REPMASK >> 11) & 1); ++rep) { if (rep) xcd_barrier(xbar);
        const float* fg = a.in[28];
        f32x4 gg[4];
#pragma unroll
        for (int j = 0; j < 4; ++j) gg[j] = *(const f32x4*)(fg + 4 * lane + 256 * j);
        constexpr int NB = 4;
        for (int mb = vw; mb < M; mb += NB * NGW) {
            f32x4 v[NB][4];
#pragma unroll
            for (int b = 0; b < NB; ++b) { const int m = mb + b * NGW;
                if (m < M) {
#pragma unroll
                    for (int j = 0; j < 4; ++j) v[b][j] = *(const f32x4*)(a.out + (size_t)m * D + 4 * lane + 256 * j); } }
#pragma unroll
            for (int b = 0; b < NB; ++b) { const int m = mb + b * NGW;
                if (m < M) { float ss = 0.f;
#pragma unroll
                    for (int j = 0; j < 4; ++j) ss += (v[b][j].x * v[b][j].x + v[b][j].y * v[b][j].y) + (v[b][j].z * v[b][j].z + v[b][j].w * v[b][j].w);
                    const float rstd = 1.0f / sqrtf(wave_sum(ss) * (1.0f / D) + EPS);
#pragma unroll
                    for (int j = 0; j < 4; ++j) *(f32x4*)(a.out + (size_t)m * D + 4 * lane + 256 * j) = v[b][j] * rstd * gg[j]; } }
        }
    }
#undef IN
#undef SEAM
}

#ifndef MK_PER_PHASE
#define MK_PER_PHASE 0
#endif
extern "C" void kernel_launch(void* const* d_in, const int* in_sizes, int n_in, void* d_out, int out_size, void* d_ws, size_t ws_size, hipStream_t stream) {
    static int grid = 0;
    if (grid == 0) {
        int dev = 0, cus = 0, per_cu = 0;
        if (n_in != 29 || ws_size < WS_END) { fprintf(stderr, "kernel_launch: unexpected n_in %d / ws %zu\n", n_in, ws_size); grid = -1; return; }
        hipGetDevice(&dev); hipDeviceGetAttribute(&cus, hipDeviceAttributeMultiprocessorCount, dev);
        hipFuncSetAttribute((const void*)mega, hipFuncAttributeMaxDynamicSharedMemorySize, LDS_BYTES);
        hipOccupancyMaxActiveBlocksPerMultiprocessor(&per_cu, (const void*)mega, 512, LDS_BYTES);
        if (per_cu < 1) { fprintf(stderr, "kernel_launch: occupancy query says %d blocks/CU\n", per_cu); per_cu = 1; }
        (void)hipGetLastError();
        grid = cus * 1;
    }
    if (grid < 0) return;
    Args a{};
    for (int i = 0; i < 29; ++i) a.in[i] = (const float*)d_in[i];
    a.out = (float*)d_out; a.ws = (unsigned char*)d_ws;
    a.ph_lo = 0; a.ph_hi = NPH;
    if (hipMemsetAsync(d_ws, 0, 16384, stream) != hipSuccess) { fprintf(stderr, "kernel_launch: memset of the barrier words failed\n"); return; }
    void* args[] = {&a};
    hipError_t e = hipLaunchCooperativeKernel((const void*)mega, dim3(grid), dim3(512), args, LDS_BYTES, stream);
    if (e != hipSuccess) fprintf(stderr, "cooperative launch failed: %s (grid %d)\n", hipGetErrorString(e), grid);
}
```

```cpp
#include <hip/hip_runtime.h>
#include <hip/hip_cooperative_groups.h>
#include <cstdio>
#include <cstdint>
namespace cg = cooperative_groups;
namespace pg8 {
#define PG8_LAS __attribute__((address_space(3)))
typedef unsigned short bf16_t;
typedef short bf16x8 __attribute__((ext_vector_type(8)));
typedef float f32x4 __attribute__((ext_vector_type(4)));
typedef unsigned u32x4 __attribute__((ext_vector_type(4)));
constexpr int BM = 256, BK = 64, HALF = 128, HTB = HALF * BK * 2  , STAGE_BYTES = 8 * HTB, NXCD = 8, WGM = 8;

__host__ __device__ __forceinline__ int lds_byte(int r, int c) { const int st = (r >> 4) * 2 + (c >> 5), rr = r & 15, cc = c & 31, ob = rr * 64 + cc * 2; return st * 1024 + (ob ^ (((ob >> 9) & 1) << 5)); }
__host__ __device__ __forceinline__ void stage_rc(int b, int& R, int& C) { const int st = b / 1024, sb = b % 1024, swz = sb ^ (((sb >> 9) & 1) << 5); R = (st >> 1) * 16 + swz / 64; C = (st & 1) * 32 + (swz % 64) / 2; }
__host__ __device__ __forceinline__ int perm32(int rho) { const int n = rho >> 4, i = rho & 15; return 8 * (i >> 2) + 4 * n + (i & 3); }

struct Unit { int pm, pn; };
struct Gemm { const bf16_t* A; const bf16_t* Bt; int M, N, K; };

struct StaticOrder {
    int nM, nN, nwg, G, c;
    __host__ __device__ void init(int M, int N, int G_, int c_) { nM = M / BM; nN = N / BM; nwg = nM * nN; G = G_; c = c_; }
    __host__ __device__ bool next(int i, Unit& u) const {
        const long L = (long)i * G + c; if (L >= nwg) return false;
        int wgid = (int)L; { const int q = nwg / NXCD, r = nwg % NXCD, xcd = wgid % NXCD, off = wgid / NXCD; wgid = (xcd < r ? xcd * (q + 1) : r * (q + 1) + (xcd - r) * q) + off; }
        const int nig = WGM * nN, gid = wgid / nig, fm = gid * WGM, gsz = (nM - fm) < WGM ? (nM - fm) : WGM;
        u.pm = fm + ((wgid % nig) % gsz); u.pn = (wgid % nig) / gsz; return true;
    }
    __device__ __forceinline__ void a_ready(const Unit&) const {}
    __device__ __forceinline__ void done(const Unit&) const {}
};
__device__ __forceinline__ unsigned cvt_pk_bf16(float lo, float hi) { unsigned r; asm volatile("v_cvt_pk_bf16_f32 %0, %1, %2" : "=v"(r) : "v"(lo), "v"(hi)); return r; }
template <class Epi, class Sched, bool ALIGN_EPI = false, bool SP2 = false>
__device__ __forceinline__ void gemm_phase(PG8_LAS unsigned char* lds, const Gemm g, const Sched& S, const Epi& E) {
    const int tid = threadIdx.x, wid = __builtin_amdgcn_readfirstlane(tid >> 6), lane = tid & 63, wr = wid >> 2, wc = wid & 3, fr = lane & 15, fq = lane >> 4;
    const int K = g.K, nt = K / BK;
    unsigned voffA[2], voffB[2];
#pragma unroll
    for (int i = 0; i < 2; ++i) { int R, C; stage_rc(tid * 16 + i * 8192, R, C); const int Rb = Epi::PERM ? ((R & ~31) + perm32(R & 31)) : R;
        voffA[i] = (unsigned)(R * K + C) * 2u; voffB[i] = (unsigned)(Rb * K + C) * 2u; }
    const size_t kstep = (size_t)(BK * 2);
    const size_t hstep = (size_t)HALF * K * 2;
    const size_t tstep = 2 * hstep;
    const unsigned ldsw = (unsigned)wid * 1024u;
    const int aoff = lds_byte(wr * 64 + fr, fq * 8), boff = lds_byte(wc * 32 + fr, fq * 8);
#define PG8_SA(b, h) (((b) * 2 + (h)) * HTB)
#define PG8_SB(b, h) ((4 + (b) * 2 + (h)) * HTB)
#define PG8_STAGE(bufoff, gbase, voff) do { _Pragma("unroll") for (int _i = 0; _i < 2; ++_i) \
        __builtin_amdgcn_global_load_lds((const unsigned*)((const char*)(gbase) + (voff)[_i]), (PG8_LAS unsigned*)(lds + (bufoff) + ldsw + _i * 8192), 16, 0, 0); } while (0)
#define PG8_LDA(dst, b, h) do { _Pragma("unroll") for (int m = 0; m < 4; ++m) _Pragma("unroll") for (int k = 0; k < 2; ++k) dst[m][k] = *(const PG8_LAS bf16x8*)(lds + PG8_SA(b, h) + aoff + m * 2048 + k * 1024); } while (0)
#define PG8_LDB(dst, b, h) do { _Pragma("unroll") for (int n = 0; n < 2; ++n) _Pragma("unroll") for (int k = 0; k < 2; ++k) dst[n][k] = *(const PG8_LAS bf16x8*)(lds + PG8_SB(b, h) + boff + n * 2048 + k * 1024); } while (0)
#define PG8_MMA(ai, bj, At, Bt) do { __builtin_amdgcn_s_setprio(1); _Pragma("unroll") for (int m = 0; m < 4; ++m) _Pragma("unroll") for (int n = 0; n < 2; ++n) _Pragma("unroll") for (int k = 0; k < 2; ++k) \
        acc[ai][bj][m][n] = __builtin_amdgcn_mfma_f32_16x16x32_bf16(Bt[n][k], At[m][k], acc[ai][bj][m][n], 0, 0, 0); __builtin_amdgcn_s_setprio(0); } while (0)
#define PG8_WAIT_V(n) asm volatile("s_waitcnt vmcnt(" #n ")" ::: "memory")
#define PG8_WAIT_L(n) asm volatile("s_waitcnt lgkmcnt(" #n ")" ::: "memory")
#define PG8_BAR __builtin_amdgcn_s_barrier()
#define PG8_SCHED __builtin_amdgcn_sched_barrier(0)
    Unit cur, nxt; int ui = 0;
    if (!S.next(0, cur)) return;
    f32x4 acc[2][2][4][2];
#pragma unroll
    for (int a = 0; a < 2; ++a)
#pragma unroll
        for (int b = 0; b < 2; ++b)
#pragma unroll
            for (int m = 0; m < 4; ++m)
#pragma unroll
                for (int n = 0; n < 2; ++n) acc[a][b][m][n] = (f32x4){0.f, 0.f, 0.f, 0.f};
    bf16x8 At[4][2], B0[2][2], B1[2][2];
    const char* cA = (const char*)g.A + (size_t)cur.pm * tstep; const char* cB = (const char*)g.Bt + (size_t)cur.pn * tstep;
    S.a_ready(cur);
    if constexpr (SP2) {
        PG8_STAGE(PG8_SB(0, 0), cB, voffB); PG8_STAGE(PG8_SB(0, 1), cB + hstep, voffB); PG8_STAGE(PG8_SA(0, 0), cA, voffA); PG8_STAGE(PG8_SA(0, 1), cA + hstep, voffA);
        if (wr == 1) PG8_BAR;
        PG8_WAIT_V(2); PG8_BAR;
        PG8_STAGE(PG8_SB(1, 0), cB + kstep, voffB); PG8_STAGE(PG8_SA(1, 0), cA + kstep, voffA); PG8_STAGE(PG8_SB(1, 1), cB + hstep + kstep, voffB);
        PG8_WAIT_V(6); PG8_BAR;
    } else {
        PG8_STAGE(PG8_SB(0, 0), cB, voffB); PG8_STAGE(PG8_SA(0, 0), cA, voffA); PG8_STAGE(PG8_SB(0, 1), cB + hstep, voffB); PG8_STAGE(PG8_SA(0, 1), cA + hstep, voffA);
        if (wr == 1) PG8_BAR;
        PG8_WAIT_V(4); PG8_BAR;
        PG8_STAGE(PG8_SB(1, 0), cB + kstep, voffB); PG8_STAGE(PG8_SA(1, 0), cA + kstep, voffA); PG8_STAGE(PG8_SB(1, 1), cB + hstep + kstep, voffB);
        PG8_WAIT_V(6); PG8_BAR;
    }
    for (;;) {
        const bool has_next = S.next(ui + 1, nxt);
        const char* nA = has_next ? (const char*)g.A + (size_t)nxt.pm * tstep : cA; const char* nB = has_next ? (const char*)g.Bt + (size_t)nxt.pn * tstep : cB;
        for (int t = 0; t < nt; t += 2) {
            const bool last = (t == nt - 2);
            const char* a1 = cA + (size_t)(t + 1) * kstep;
            const char* a2 = last ? nA : cA + (size_t)(t + 2) * kstep; const char* b2 = last ? nB : cB + (size_t)(t + 2) * kstep;
            const char* a3 = a2 + kstep; const char* b3 = b2 + kstep;
            if (last && has_next) S.a_ready(nxt);
            if constexpr (SP2) {
            PG8_LDB(B0, 0, 0); PG8_LDB(B1, 0, 1); PG8_SCHED; PG8_LDA(At, 0, 0); PG8_STAGE(PG8_SA(1, 1), a1 + hstep, voffA);
            PG8_WAIT_V(8); PG8_WAIT_L(0); PG8_BAR; PG8_MMA(0, 0, At, B0); PG8_MMA(0, 1, At, B1); PG8_BAR; PG8_SCHED;
            PG8_LDA(At, 0, 1); PG8_STAGE(PG8_SB(0, 0), b2, voffB); PG8_STAGE(PG8_SB(0, 1), b2 + hstep, voffB); PG8_STAGE(PG8_SA(0, 0), a2, voffA);
            PG8_WAIT_V(8); PG8_WAIT_L(0); PG8_BAR; PG8_MMA(1, 0, At, B0); PG8_MMA(1, 1, At, B1); PG8_BAR; PG8_SCHED;
            PG8_LDB(B0, 1, 0); PG8_LDB(B1, 1, 1); PG8_SCHED; PG8_LDA(At, 1, 0); PG8_STAGE(PG8_SA(0, 1), a2 + hstep, voffA);
            PG8_WAIT_V(8); PG8_WAIT_L(0); PG8_BAR; PG8_MMA(0, 0, At, B0); PG8_MMA(0, 1, At, B1); PG8_BAR; PG8_SCHED;
            PG8_LDA(At, 1, 1); PG8_STAGE(PG8_SB(1, 0), b3, voffB); PG8_STAGE(PG8_SB(1, 1), b3 + hstep, voffB); PG8_STAGE(PG8_SA(1, 0), a3, voffA);
            PG8_WAIT_V(8); PG8_WAIT_L(0); PG8_BAR; PG8_MMA(1, 0, At, B0); PG8_MMA(1, 1, At, B1); PG8_BAR; PG8_SCHED;
            } else {
            PG8_LDB(B0, 0, 0); PG8_SCHED; PG8_LDA(At, 0, 0); PG8_STAGE(PG8_SA(1, 1), a1 + hstep, voffA);
            PG8_WAIT_L(8); PG8_BAR; PG8_WAIT_L(0); PG8_MMA(0, 0, At, B0); PG8_BAR; PG8_SCHED;
            PG8_LDB(B1, 0, 1); PG8_STAGE(PG8_SB(0, 0), b2, voffB);
            PG8_BAR; PG8_WAIT_L(0); PG8_MMA(0, 1, At, B1); PG8_BAR;
            PG8_LDA(At, 0, 1); PG8_STAGE(PG8_SA(0, 0), a2, voffA);
            PG8_BAR; PG8_WAIT_L(0); PG8_MMA(1, 0, At, B0); PG8_BAR; PG8_SCHED;
            PG8_STAGE(PG8_SB(0, 1), b2 + hstep, voffB);
            PG8_WAIT_V(6); PG8_BAR; PG8_MMA(1, 1, At, B1); PG8_BAR;
            PG8_LDB(B0, 1, 0); PG8_SCHED; PG8_LDA(At, 1, 0); PG8_STAGE(PG8_SA(0, 1), a2 + hstep, voffA);
            PG8_WAIT_L(8); PG8_BAR; PG8_WAIT_L(0); PG8_MMA(0, 0, At, B0); PG8_BAR; PG8_SCHED;
            PG8_LDB(B1, 1, 1); PG8_STAGE(PG8_SB(1, 0), b3, voffB);
            PG8_BAR; PG8_WAIT_L(0); PG8_MMA(0, 1, At, B1); PG8_BAR;
            PG8_LDA(At, 1, 1); PG8_STAGE(PG8_SA(1, 0), a3, voffA);
            PG8_BAR; PG8_WAIT_L(0); PG8_MMA(1, 0, At, B0); PG8_BAR; PG8_SCHED;
            PG8_STAGE(PG8_SB(1, 1), b3 + hstep, voffB);
            PG8_WAIT_V(6); PG8_BAR; PG8_MMA(1, 1, At, B1); PG8_BAR;
            }
        }
        if constexpr (ALIGN_EPI) { if (wr == 0) PG8_BAR; }
        if constexpr (!Epi::AFTER_DRAIN) { E(acc, cur, wr, wc, fr, fq); S.done(cur); }
        if (!has_next) break;
#pragma unroll
        for (int a = 0; a < 2; ++a)
#pragma unroll
            for (int b = 0; b < 2; ++b)
#pragma unroll
                for (int m = 0; m < 4; ++m)
#pragma unroll
                    for (int n = 0; n < 2; ++n) acc[a][b][m][n] = (f32x4){0.f, 0.f, 0.f, 0.f};
        cur = nxt; cA = nA; cB = nB; ++ui;
        if constexpr (ALIGN_EPI) { if (wr == 1) PG8_BAR; }
    }
    PG8_WAIT_V(0);
    if constexpr (!ALIGN_EPI) { if (wr == 0) PG8_BAR; }
    PG8_BAR;
    if constexpr (Epi::AFTER_DRAIN) { E.fused(acc, cur, wr, wc, fr, fq, lds, wid, lane); S.done(cur); }
#undef PG8_SA
#undef PG8_SB
#undef PG8_STAGE
#undef PG8_LDA
#undef PG8_LDB
#undef PG8_MMA
#undef PG8_WAIT_V
#undef PG8_WAIT_L
#undef PG8_BAR
#undef PG8_SCHED
}
}

#define GAS __attribute__((address_space(1)))
#define LAS __attribute__((address_space(3)))
typedef unsigned short bf16;
typedef unsigned v4u __attribute__((ext_vector_type(4)));
typedef unsigned v2u __attribute__((ext_vector_type(2)));
typedef float f32x4 __attribute__((ext_vector_type(4)));
typedef float f32x2 __attribute__((ext_vector_type(2)));
typedef float f32x16 __attribute__((ext_vector_type(16)));
typedef short bf16x8 __attribute__((ext_vector_type(8)));
using pg8::cvt_pk_bf16;

constexpr int D = 1024, SEQ = 16384, NSB = 8, NST = 32, M = SEQ + NSB * NST  , INW = 1536, DFF = 2816, GUW = 2 * DFF, NMOD = 6 * D;
constexpr int NCH = M / 32;
constexpr float EPS = 1e-6f;
constexpr size_t O_PRE = (size_t)M * D, O_PIM = O_PRE + 2048, O_SRE = O_PIM + 2048, O_SIM = O_SRE + 16384, O_V = O_SIM + 16384;

constexpr size_t MiB = 1u << 20, KiB = 1u << 10;
constexpr size_t WS_MODP = 240 * MiB;
constexpr int NKS = 16;
constexpr size_t WS_MODF = 2 * MiB;
constexpr size_t WS_TB = 2 * MiB + 512 * KiB;
constexpr size_t WS_TC = WS_TB + 128 * KiB;
constexpr size_t WS_TA = WS_TC + 128 * KiB;
constexpr size_t WS_TP = WS_TA + 64 * KiB;
constexpr size_t WS_STATS = 3 * MiB;
constexpr size_t WS_WIN = 4 * MiB, WS_WGLU = 7 * MiB, WS_WOUT = 8 * MiB, WS_WGU = 10 * MiB, WS_WD = 21 * MiB;
constexpr size_t WS_SLOC = 27 * MiB, WS_SST = 35 * MiB;
constexpr size_t WS_H = 44 * MiB;
constexpr size_t WS_X1 = 77 * MiB;
constexpr size_t ACT5 = (size_t)M * 512 * 2;
constexpr size_t WS_ZS5 = 142 * MiB, WS_UG = WS_ZS5 + ACT5, WS_GV = WS_UG + ACT5, WS_YS = WS_GV + ACT5, WS_CAT = WS_YS + ACT5;
constexpr size_t WS_HID = 142 * MiB;
constexpr size_t WS_END = WS_CAT + (size_t)M * 1024 * 2;
static_assert(WS_END <= 256 * MiB && WS_HID + (size_t)M * DFF * 2 <= WS_END, "ws map");
constexpr int LDS_BYTES = 147456;
constexpr int NPH = 12;

__device__ __forceinline__ float bf2f(unsigned short b) { return __builtin_bit_cast(float, ((unsigned)b) << 16); }
__device__ __forceinline__ float bflo(unsigned w) { return __builtin_bit_cast(float, w << 16); }
__device__ __forceinline__ float bfhi(unsigned w) { return __builtin_bit_cast(float, w & 0xffff0000u); }
__device__ __forceinline__ float sigm(float x) { return __builtin_amdgcn_rcpf(1.f + __expf(-x)); }
__device__ __forceinline__ float gelu_t(float x) { const float z = 1.5957691216f * (x + 0.044715f * x * x * x); return x * sigm(z); }
__device__ __forceinline__ float silu_f(float x) { return x * sigm(x); }
__device__ __forceinline__ float wave_sum(float v) {
#pragma unroll
    for (int o = 1; o < 64; o <<= 1) v += __shfl_xor(v, o);
    return v;
}
#define LDS_WAIT() asm volatile("s_waitcnt lgkmcnt(0)" ::: "memory")

#define XB_TMO      128
#define XB_XCNT(j)  (256  + 64 * (j))
#define XB_XSUB(j)  (1280 + 64 * (j))
#define XB_XGEN(j)  (2304 + 64 * (j))
#define XB_TOP      3328
#define XB_TOPGEN   3392
#define XCD_BAR_WORDS 3456
#define XB_SPIN_CAP (1u << 18)

__device__ __forceinline__ unsigned xb_ld(unsigned* p)              { return __hip_atomic_load(p, __ATOMIC_RELAXED, __HIP_MEMORY_SCOPE_AGENT); }
__device__ __forceinline__ unsigned xb_add(unsigned* p, unsigned v) { return __hip_atomic_fetch_add(p, v, __ATOMIC_RELAXED, __HIP_MEMORY_SCOPE_AGENT); }
__device__ __forceinline__ unsigned xb_xcc_id() { return (unsigned)__builtin_amdgcn_s_getreg((3 << 11) | 20) & 0xFu; }
#define XB_SPIN(cond, bar) do { unsigned _sp = 0; while (cond) { __builtin_amdgcn_s_sleep(1); \
    if ((++_sp & 255u) == 0u) { if (xb_ld(&(bar)[XB_TMO])) break; if (_sp > XB_SPIN_CAP) { atomicAdd(&(bar)[XB_TMO], 1u); break; } } } } while (0)

struct XcdBarrier {
    unsigned* bar; unsigned x;
    volatile LAS unsigned* st;
};

__device__ __forceinline__ XcdBarrier xcd_barrier_post(unsigned* bar, volatile LAS unsigned* st) {
    XcdBarrier b; b.bar = bar; b.x = xb_xcc_id(); b.st = st;
    if (threadIdx.x == 0) (void)xb_add(&bar[XB_XCNT(b.x)], 1u);
    return b;
}
__device__ __forceinline__ void xcd_barrier_complete(unsigned* bar, unsigned x, unsigned& nloc, unsigned& nx) {
    const unsigned G = gridDim.x * gridDim.y * gridDim.z;
    unsigned sum, cnt, mine, sp = 0u;
    for (;;) {
        sum = 0u; cnt = 0u; mine = 0u;
#pragma unroll
        for (unsigned j = 0; j < 16; ++j) { const unsigned c = xb_ld(&bar[XB_XCNT(j)]); sum += c; cnt += (c > 0u) ? 1u : 0u; mine = (j == x) ? c : mine; }
        if (sum == G) break;
        __builtin_amdgcn_s_sleep(1);
        if ((++sp & 255u) == 0u) { if (xb_ld(&bar[XB_TMO])) break; if (sp > XB_SPIN_CAP) { atomicAdd(&bar[XB_TMO], 1u); break; } }
    }
    nloc = mine > 0u ? mine : 1u; nx = cnt > 0u ? cnt : 1u;
}

__device__ __forceinline__ void xcd_barrier(const XcdBarrier& b) {
    asm volatile("s_waitcnt vmcnt(0)" ::: "memory");
    __syncthreads();
    if (threadIdx.x == 0) {
        unsigned* bar = b.bar;
        __builtin_amdgcn_s_waitcnt(0);
        unsigned nloc = b.st[0], nx = b.st[1];
        if (nloc == 0u) { xcd_barrier_complete(bar, b.x, nloc, nx); b.st[0] = nloc; b.st[1] = nx; }
        const unsigned old = xb_add(&bar[XB_XSUB(b.x)], 1u);
        const unsigned gen = old / nloc;
        if (old + 1u == (gen + 1u) * nloc) {
            __builtin_amdgcn_fence(__ATOMIC_RELEASE, "agent");
            asm volatile("s_waitcnt vmcnt(0)" ::: "memory");
            const unsigned og = xb_add(&bar[XB_TOP], 1u);
            const unsigned tg = og / nx;
            if (og + 1u == (tg + 1u) * nx) xb_add(&bar[XB_TOPGEN], 1u);
            else XB_SPIN(xb_ld(&bar[XB_TOPGEN]) == tg, bar);
            __builtin_amdgcn_fence(__ATOMIC_ACQUIRE, "agent");
            xb_add(&bar[XB_XGEN(b.x)], 1u);
            asm volatile("s_waitcnt vmcnt(0)" ::: "memory");
        } else {
            XB_SPIN(xb_ld(&bar[XB_XGEN(b.x)]) == gen, bar);
            __builtin_amdgcn_fence(__ATOMIC_ACQUIRE, "agent");
            asm volatile("s_waitcnt vmcnt(0)" ::: "memory");
        }
    }
    __syncthreads();
}

struct Args { const float* in[29]; float* out; unsigned char* ws; int ph_lo, ph_hi; };

__device__ __forceinline__ void p0_transpose_item(const float* W, int K, int N, bf16* WT, int dst_row0, LAS float* scr, int kb, int nb, int lane) {
    const int k0 = 64 * kb, n0 = 32 * nb;
#pragma unroll
    for (int i = 0; i < 32; ++i) { const int kk = 2 * i + (lane >> 5); scr[kk * 33 + (lane & 31)] = W[(size_t)(k0 + kk) * N + n0 + (lane & 31)]; }
    LDS_WAIT();
    const int c = lane & 7;
#pragma unroll
    for (int j = 0; j < 4; ++j) { const int n = (lane >> 3) + 8 * j; const LAS float* s = scr + (8 * c) * 33 + n;
        v4u o; o.x = cvt_pk_bf16(s[0 * 33], s[1 * 33]); o.y = cvt_pk_bf16(s[2 * 33], s[3 * 33]); o.z = cvt_pk_bf16(s[4 * 33], s[5 * 33]); o.w = cvt_pk_bf16(s[6 * 33], s[7 * 33]);
        *(v4u*)(WT + (size_t)(dst_row0 + n) * K + k0 + 8 * c) = o; }
    LDS_WAIT();
}
__device__ __forceinline__ float rl(float v, int l) { return __builtin_bit_cast(float, __builtin_amdgcn_readlane(__builtin_bit_cast(int, v), l)); }

__device__ __forceinline__ void p0_ada_item(const Args& a, int cs, int ks, int lane) {
    const float* cp = a.in[4]; const float* csm = a.in[5]; const float* W = a.in[8];
    float* modp = (float*)(a.ws + WS_MODP);
    const int c0 = cs * 256 + 4 * lane, k0 = ks * 64;
    float sl[9];
#pragma unroll
    for (int b = 0; b < 9; ++b) { const int k = k0 + lane; const float cv = (b == 0) ? cp[k] : csm[(b - 1) * D + k]; sl[b] = silu_f(cv); }
    f32x4 acc[9];
#pragma unroll
    for (int b = 0; b < 9; ++b) acc[b] = (f32x4){0.f, 0.f, 0.f, 0.f};
#pragma unroll 16
    for (int kk = 0; kk < 64; ++kk) {
        const f32x4 w = *(const f32x4*)(W + (size_t)(k0 + kk) * NMOD + c0);
#pragma unroll
        for (int b = 0; b < 9; ++b) { const float s = rl(sl[b], kk); acc[b] += w * s; }
    }
#pragma unroll
    for (int b = 0; b < 9; ++b) *(f32x4*)(modp + ((size_t)ks * 9 + b) * NMOD + c0) = acc[b];
}

__device__ __forceinline__ void p0_s5_tables(const Args& a, int g, int lane) {
    const int n = lane;
    const float step = expf(a.in[13][g]);
    const float lr = a.in[11][g * 64 + n], li = a.in[12][g * 64 + n];
    const float x = lr * step, y = li * step;
    const float ex = expf(x), cy = cosf(y), sy = sinf(y), sh = sinf(0.5f * y);
    const float a1r = ex * cy, a1i = ex * sy;
    const float mr = expm1f(x) * cy - 2.f * sh * sh, mi = ex * sy;
    const float den = lr * lr + li * li;
    const float fr = (mr * lr + mi * li) / den, fi = (mi * lr - mr * li) / den;
    bf16* TB = (bf16*)(a.ws + WS_TB); bf16* TC = (bf16*)(a.ws + WS_TC); float* TA = (float*)(a.ws + WS_TA); float* TP = (float*)(a.ws + WS_TP);
    const float* br = a.in[14] + (size_t)(g * 64 + n) * 16; const float* bi = a.in[15] + (size_t)(g * 64 + n) * 16;
    const int xx = n >> 1, sbit = n & 1;
    bf16* rowre = TB + (size_t)(g * 128 + (0 + sbit) * 32 + xx) * 16;
    bf16* rowim = TB + (size_t)(g * 128 + (2 + sbit) * 32 + xx) * 16;
#pragma unroll
    for (int q = 0; q < 16; q += 2) {
        const float b0r = br[q], b0i = bi[q], b1r = br[q + 1], b1i = bi[q + 1];
        *(unsigned*)(rowre + q) = cvt_pk_bf16(fr * b0r - fi * b0i, fr * b1r - fi * b1i);
        *(unsigned*)(rowim + q) = cvt_pk_bf16(fr * b0i + fi * b0r, fr * b1i + fi * b1r);
    }
    double pr = a1r, pi = a1i;
    double p2r = pr * pr - pi * pi, p2i = 2.0 * pr * pi;
    double p3r = p2r * pr - p2i * pi, p3i = p2r * pi + p2i * pr;
    double p4r = p2r * p2r - p2i * p2i, p4i = 2.0 * p2r * p2i;
    float* ta = TA + (size_t)(g * 64 + n) * 8;
    ta[0] = (float)pr; ta[1] = (float)pi; ta[2] = (float)p2r; ta[3] = (float)p2i; ta[4] = (float)p3r; ta[5] = (float)p3i; ta[6] = (float)p4r; ta[7] = (float)p4i;
    double qr = p4r, qi = p4i;
#pragma unroll
    for (int s = 0; s < 3; ++s) { const double t = qr * qr - qi * qi; qi = 2.0 * qr * qi; qr = t; }
    float* tp = TP + (size_t)(g * 64 + n) * 4;
    tp[0] = (float)qr; tp[1] = (float)qi;
#pragma unroll
    for (int s = 0; s < 6; ++s) { const double t = qr * qr - qi * qi; qi = 2.0 * qr * qi; qr = t; }
    tp[2] = (float)qr; tp[3] = (float)qi;
    const float* cr = a.in[16] + (size_t)g * 16 * 64; const float* ci = a.in[17] + (size_t)g * 16 * 64;
#pragma unroll
    for (int p = 0; p < 16; ++p) { TC[(size_t)(g * 16 + p) * 128 + n] = (bf16)(cvt_pk_bf16(cr[p * 64 + n], 0.f) & 0xffffu); TC[(size_t)(g * 16 + p) * 128 + 64 + n] = (bf16)(cvt_pk_bf16(-ci[p * 64 + n], 0.f) & 0xffffu); }
}

__device__ __forceinline__ void p0_prologue(const Args& a, LAS unsigned char* lds, int vw, int NGW, int wave, int lane) {
    LAS float* scr = (LAS float*)(lds + wave * 16384);
    constexpr int I_ADA = 24 * NKS, I_S5 = 32, I_IN = 16 * 48, I_GLU = 8 * 16, I_OUT = 16 * 32, I_GU = 16 * 176, I_D = 44 * 32;
    constexpr int NITEMS = I_ADA + I_S5 + I_IN + I_GLU + I_OUT + I_GU + I_D;
    for (int it = vw; it < NITEMS; it += NGW) {
        int r = it;
        if (r < I_ADA) { p0_ada_item(a, r % 24, r / 24, lane); continue; } r -= I_ADA;
        if (r < I_S5) { p0_s5_tables(a, r, lane); continue; } r -= I_S5;
        if (r < I_IN) { const int nblk = INW / 32, kb = r / nblk, nb = r % nblk; p0_transpose_item(a.in[10], D, INW, (bf16*)(a.ws + WS_WIN), 32 * nb, scr, kb, nb, lane); continue; } r -= I_IN;
        if (r < I_GLU) { const int nblk = 16, kb = r / nblk, nb = r % nblk; p0_transpose_item(a.in[19], 512, 512, (bf16*)(a.ws + WS_WGLU), 32 * nb, scr, kb, nb, lane); continue; } r -= I_GLU;
        if (r < I_OUT) { const int nblk = 32, kb = r / nblk, nb = r % nblk; p0_transpose_item(a.in[25], D, D, (bf16*)(a.ws + WS_WOUT), 32 * nb, scr, kb, nb, lane); continue; } r -= I_OUT;
        if (r < I_GU) { const int nblk = GUW / 32, kb = r / nblk, nb = r % nblk; const int n0 = 32 * nb; const int j = n0 < DFF ? n0 : n0 - DFF;
            const int drow = 256 * (j >> 7) + (n0 < DFF ? 0 : 128) + (j & 127);
            p0_transpose_item(a.in[26], D, GUW, (bf16*)(a.ws + WS_WGU), drow, scr, kb, nb, lane); continue; } r -= I_GU;
        { const int nblk = 32, kb = r / nblk, nb = r % nblk; p0_transpose_item(a.in[27], DFF, D, (bf16*)(a.ws + WS_WD), 32 * nb, scr, kb, nb, lane); }
    }
}

template <int WHICH>
__device__ __forceinline__ void hprep(const Args& a, int vw, int NGW, int lane, LAS float* lco) {
    const float* gvec = a.in[WHICH == 0 ? 6 : 7];
    const float* modp = (const float*)(a.ws + WS_MODP); const float* modf = (const float*)(a.ws + WS_MODF); const float* bada = a.in[9];
    bf16* H = (bf16*)(a.ws + WS_H);
    const int soff = WHICH == 0 ? 0 : 3 * D, coff = soff + D;
    int cur = -1; f32x4 ca[4], cb[4];
    constexpr int NB = 4;
    for (int mb = vw; mb < M; mb += NB * NGW) {
        f32x4 v[NB][4];
#pragma unroll
        for (int b = 0; b < NB; ++b) { const int m = mb + b * NGW;
            if (m < M) { const float* xrow = WHICH == 0 ? (m < SEQ ? a.in[0] + (size_t)m * D : a.in[1] + (size_t)(m - SEQ) * D) : (const float*)(a.ws + WS_X1) + (size_t)m * D;
#pragma unroll
                for (int j = 0; j < 4; ++j) v[b][j] = *(const f32x4*)(xrow + 4 * lane + 256 * j); } }
#pragma unroll
        for (int b = 0; b < NB; ++b) { const int m = mb + b * NGW;
            if (m < M) {
                const int mr = m < SEQ ? 0 : 1 + ((m - SEQ) >> 5);
                if (mr != cur) { cur = mr;
#pragma unroll
                    for (int j = 0; j < 4; ++j) { const int k = 4 * lane + 256 * j; f32x4 sc, sh;
                        if (WHICH == 0 && mr == 0) { sc = *(const LAS f32x4*)(lco + k); sh = *(const LAS f32x4*)(lco + D + k); }
                        else if (WHICH == 0) { sc = *(const f32x4*)(bada + coff + k); sh = *(const f32x4*)(bada + soff + k);
#pragma unroll
                            for (int ks = 0; ks < NKS; ++ks) { sc += *(const f32x4*)(modp + ((size_t)ks * 9 + mr) * NMOD + coff + k); sh += *(const f32x4*)(modp + ((size_t)ks * 9 + mr) * NMOD + soff + k); } }
                        else { sc = *(const f32x4*)(modf + (size_t)mr * NMOD + coff + k); sh = *(const f32x4*)(modf + (size_t)mr * NMOD + soff + k); }
                        const f32x4 gg = *(const f32x4*)(gvec + k); ca[j] = gg * (sc + 1.0f); cb[j] = sh; } }
                float ss = 0.f;
#pragma unroll
                for (int j = 0; j < 4; ++j) ss += (v[b][j].x * v[b][j].x + v[b][j].y * v[b][j].y) + (v[b][j].z * v[b][j].z + v[b][j].w * v[b][j].w);
                const float rstd = 1.0f / sqrtf(wave_sum(ss) * (1.0f / D) + EPS);
#pragma unroll
                for (int j = 0; j < 4; ++j) { const f32x4 o = v[b][j] * rstd * ca[j] + cb[j]; v2u w; w.x = cvt_pk_bf16(o.x, o.y); w.y = cvt_pk_bf16(o.z, o.w);
                    *(v2u*)(H + (size_t)m * D + 4 * lane + 256 * j) = w; }
            } }
    }
}

using pg8::Unit;
struct EpiIn {
    static constexpr bool PERM = true, AFTER_DRAIN = false;
    bf16 *zs5, *ug, *gv;
    __device__ __forceinline__ void operator()(const f32x4 (&acc)[2][2][4][2], const Unit& u, int wr, int wc, int fr, int fq) const {
        const int sec = u.pn >> 1; bf16* base = zs5 + (size_t)sec * (ACT5 / 2);
        const int row0 = u.pm * 256 + wr * 64 + fr, col0 = (u.pn & 1) * 256 + wc * 32 + 8 * fq;
#pragma unroll
        for (int ai = 0; ai < 2; ++ai)
#pragma unroll
            for (int m = 0; m < 4; ++m) { bf16* rowp = base + (size_t)(row0 + ai * 128 + m * 16) * 512 + col0;
#pragma unroll
                for (int bj = 0; bj < 2; ++bj) { const f32x4 v0 = acc[ai][bj][m][0], v1 = acc[ai][bj][m][1];
                    v4u w;
                    if (sec) { w.x = cvt_pk_bf16(gelu_t(v0.x), gelu_t(v0.y)); w.y = cvt_pk_bf16(gelu_t(v0.z), gelu_t(v0.w)); w.z = cvt_pk_bf16(gelu_t(v1.x), gelu_t(v1.y)); w.w = cvt_pk_bf16(gelu_t(v1.z), gelu_t(v1.w)); }
                    else { w.x = cvt_pk_bf16(v0.x, v0.y); w.y = cvt_pk_bf16(v0.z, v0.w); w.z = cvt_pk_bf16(v1.x, v1.y); w.w = cvt_pk_bf16(v1.z, v1.w); }
                    *(v4u*)(rowp + bj * 128) = w; }
                asm volatile("" ::: "memory"); }
    }
};
struct EpiGlu {
    static constexpr bool PERM = true, AFTER_DRAIN = false;
    const bf16* ys; bf16* cat; const float* bias;
    __device__ __forceinline__ void operator()(const f32x4 (&acc)[2][2][4][2], const Unit& u, int wr, int wc, int fr, int fq) const {
        const int row0 = u.pm * 256 + wr * 64 + fr, col0 = u.pn * 256 + wc * 32 + 8 * fq;
        f32x4 bv[2][2];
#pragma unroll
        for (int bj = 0; bj < 2; ++bj)
#pragma unroll
            for (int n = 0; n < 2; ++n) bv[bj][n] = *(const f32x4*)(bias + col0 + bj * 128 + 4 * n);
#pragma unroll
        for (int ai = 0; ai < 2; ++ai)
#pragma unroll
            for (int m = 0; m < 4; ++m) { const size_t r = (size_t)(row0 + ai * 128 + m * 16);
#pragma unroll
                for (int bj = 0; bj < 2; ++bj) { const f32x4 g0 = acc[ai][bj][m][0] + bv[bj][0], g1 = acc[ai][bj][m][1] + bv[bj][1];
                    const v4u y = *(const v4u*)(ys + r * 512 + col0 + bj * 128);
                    v4u w;
                    w.x = cvt_pk_bf16(bflo(y.x) * sigm(g0[0]), bfhi(y.x) * sigm(g0[1])); w.y = cvt_pk_bf16(bflo(y.y) * sigm(g0[2]), bfhi(y.y) * sigm(g0[3]));
                    w.z = cvt_pk_bf16(bflo(y.z) * sigm(g1[0]), bfhi(y.z) * sigm(g1[1])); w.w = cvt_pk_bf16(bflo(y.w) * sigm(g1[2]), bfhi(y.w) * sigm(g1[3]));
                    *(v4u*)(cat + r * 1024 + col0 + bj * 128) = w; } }
    }
};
struct EpiRes {
    static constexpr bool PERM = false, AFTER_DRAIN = false;
    const float* bp; const float* bs; const float* gate  ; float* out;
    __device__ __forceinline__ void operator()(const f32x4 (&acc)[2][2][4][2], const Unit& u, int wr, int wc, int fr, int fq) const {
        const int col0 = u.pn * 256 + wc * 32 + 4 * fq;
        f32x4 g[2][2];
#pragma unroll
        for (int bj = 0; bj < 2; ++bj)
#pragma unroll
            for (int n = 0; n < 2; ++n) g[bj][n] = *(const f32x4*)(gate + col0 + bj * 128 + n * 16);
#pragma unroll
        for (int ai = 0; ai < 2; ++ai) {
            f32x4 b[4][2][2];
#pragma unroll
            for (int m = 0; m < 4; ++m) { const size_t row = (size_t)(u.pm * 256 + ai * 128 + wr * 64 + m * 16 + fr);
#pragma unroll
                for (int bj = 0; bj < 2; ++bj)
#pragma unroll
                    for (int n = 0; n < 2; ++n) b[m][bj][n] = *(const f32x4*)(bp + row * D + col0 + bj * 128 + n * 16); }
            asm volatile("" ::: "memory");
#pragma unroll
            for (int m = 0; m < 4; ++m) { const size_t row = (size_t)(u.pm * 256 + ai * 128 + wr * 64 + m * 16 + fr);
#pragma unroll
                for (int bj = 0; bj < 2; ++bj)
#pragma unroll
                    for (int n = 0; n < 2; ++n) *(f32x4*)(out + row * D + col0 + bj * 128 + n * 16) = b[m][bj][n] + g[bj][n] * acc[ai][bj][m][n]; }
            asm volatile("" ::: "memory");
        }
    }
};
struct EpiGU {
    static constexpr bool PERM = true, AFTER_DRAIN = false;
    bf16* hid;
    __device__ __forceinline__ void operator()(const f32x4 (&acc)[2][2][4][2], const Unit& u, int wr, int wc, int fr, int fq) const {
        const int row0 = u.pm * 256 + wr * 64 + fr, col0 = u.pn * 128 + wc * 32 + 8 * fq;
#pragma unroll
        for (int ai = 0; ai < 2; ++ai)
#pragma unroll
            for (int m = 0; m < 4; ++m) { bf16* rowp = hid + (size_t)(row0 + ai * 128 + m * 16) * DFF + col0;
                const f32x4 g0 = acc[ai][0][m][0], g1 = acc[ai][0][m][1], u0 = acc[ai][1][m][0], u1 = acc[ai][1][m][1];
                v4u w; w.x = cvt_pk_bf16(silu_f(g0[0]) * u0[0], silu_f(g0[1]) * u0[1]); w.y = cvt_pk_bf16(silu_f(g0[2]) * u0[2], silu_f(g0[3]) * u0[3]);
                w.z = cvt_pk_bf16(silu_f(g1[0]) * u1[0], silu_f(g1[1]) * u1[1]); w.w = cvt_pk_bf16(silu_f(g1[2]) * u1[2], silu_f(g1[3]) * u1[3]);
                *(v4u*)rowp = w; }
    }
};

#define MFMA32(a, b, c) __builtin_amdgcn_mfma_f32_32x32x16_bf16((a), (b), (c), 0, 0, 0)
#define MFMA16(a, b, c) __builtin_amdgcn_mfma_f32_16x16x32_bf16((a), (b), (c), 0, 0, 0)
template <bool FULL>
__device__ __forceinline__ void s5_phase(const Args& a, LAS unsigned char* sbuf, int vw, int NGW, int lane, int nitems) {
    const int half = lane >> 5, x = lane & 31, l15 = lane & 15, q4 = lane >> 4;
    const bf16* ZS5 = (const bf16*)(a.ws + WS_ZS5);
    const bf16* TB = (const bf16*)(a.ws + WS_TB); const float* TA = (const float*)(a.ws + WS_TA); const bf16* TC = (const bf16*)(a.ws + WS_TC);
    bf16* YS = (bf16*)(a.ws + WS_YS);
    int curg = -1;
    bf16x8 tb[4], tc[4]; f32x4 ta[2][2]; f32x4 dd;
    int it = vw; if (it >= nitems) return;
    bf16x8 un = *(const bf16x8*)(ZS5 + (size_t)((it >> 5) * 32 + x) * 512 + (it & 31) * 16 + half * 8);
    for (; it < nitems; it += NGW) {
        const int g = it & 31, ch = it >> 5, m0 = ch * 32;
        if (g != curg) { curg = g;
#pragma unroll
            for (int c = 0; c < 4; ++c) tb[c] = *(const bf16x8*)(TB + (size_t)(g * 128 + c * 32 + x) * 16 + half * 8);
#pragma unroll
            for (int s = 0; s < 2; ++s) { ta[s][0] = *(const f32x4*)(TA + (size_t)(g * 64 + 2 * x + s) * 8); ta[s][1] = *(const f32x4*)(TA + (size_t)(g * 64 + 2 * x + s) * 8 + 4); }
            if (FULL) {
#pragma unroll
                for (int ks = 0; ks < 4; ++ks) tc[ks] = *(const bf16x8*)(TC + (size_t)(g * 16 + l15) * 128 + ks * 32 + q4 * 8);
                dd = *(const f32x4*)(a.in[18] + g * 16 + q4 * 4); }
        }
        const bf16x8 ua = un;
        { const int nx = it + NGW; if (nx < nitems) un = *(const bf16x8*)(ZS5 + (size_t)((nx >> 5) * 32 + x) * 512 + (nx & 31) * 16 + half * 8); }
        float cin0r = 0.f, cin0i = 0.f, cin1r = 0.f, cin1i = 0.f;
        if (FULL) {
            if (ch >= 512) { const int b = ch - 512; const f32x2 r2 = *(const f32x2*)(a.in[2] + (size_t)(b * 32 + g) * 64 + 2 * x), i2 = *(const f32x2*)(a.in[3] + (size_t)(b * 32 + g) * 64 + 2 * x);
                cin0r = r2.x; cin1r = r2.y; cin0i = i2.x; cin1i = i2.y; }
            else if (ch > 0) { const float* sst = (const float*)(a.ws + WS_SST) + (size_t)(ch * 32 + g) * 128; const f32x2 r2 = *(const f32x2*)(sst + 2 * x), i2 = *(const f32x2*)(sst + 64 + 2 * x);
                cin0r = r2.x; cin1r = r2.y; cin0i = i2.x; cin1i = i2.y; }
        }
        v2u uu[2];
        if (FULL) {
#pragma unroll
            for (int tt = 0; tt < 2; ++tt) uu[tt] = *(const v2u*)(ZS5 + (size_t)(m0 + tt * 16 + l15) * 512 + g * 16 + q4 * 4); }
        f32x16 acc[4];
#pragma unroll
        for (int c = 0; c < 4; ++c) { f32x16 z;
#pragma unroll
            for (int r = 0; r < 16; ++r) z[r] = 0.f;
            acc[c] = MFMA32(ua, tb[c], z); }
        float endr[2], endi[2];
#pragma unroll
        for (int s = 0; s < 2; ++s) {
            const f32x4 t0 = ta[s][0], t1 = ta[s][1];
            const float apr[4] = {t0.x, t0.z, t1.x, t1.z}, api[4] = {t0.y, t0.w, t1.y, t1.w};
            const float a1r = apr[0], a1i = api[0], a4r = apr[3], a4i = api[3];
            f32x16& R = acc[s]; f32x16& I = acc[2 + s];
#pragma unroll
            for (int i = 0; i < 4; ++i)
#pragma unroll
                for (int j = 1; j < 4; ++j) { const int r = 4 * i + j; const float pr = R[r - 1], pi = I[r - 1];
                    R[r] += a1r * pr - a1i * pi; I[r] += a1r * pi + a1i * pr; }
            float cr = s ? cin1r : cin0r, ci = s ? cin1i : cin0i;
            float cinr[4], cini[4];
#pragma unroll
            for (int i = 0; i < 4; ++i) {
                const float lr_ = R[4 * i + 3], li_ = I[4 * i + 3];
                const float candr = a4r * cr - a4i * ci + lr_, candi = a4r * ci + a4i * cr + li_;
                const float othr = __shfl_xor(candr, 32), othi = __shfl_xor(candi, 32);
                cinr[i] = half ? othr : cr; cini[i] = half ? othi : ci;
                const float outr = a4r * cinr[i] - a4i * cini[i] + lr_, outi = a4r * cini[i] + a4i * cinr[i] + li_;
                cr = __shfl_xor(outr, 32); ci = __shfl_xor(outi, 32);
            }
            endr[s] = cr; endi[s] = ci;
            if (FULL) {
#pragma unroll
                for (int i = 0; i < 4; ++i)
#pragma unroll
                    for (int j = 0; j < 4; ++j) { const int r = 4 * i + j;
                        R[r] += apr[j] * cinr[i] - api[j] * cini[i]; I[r] += apr[j] * cini[i] + api[j] * cinr[i]; }
            }
        }
        if (!FULL) {
            if (half == 0) { float* sl = (float*)(a.ws + WS_SLOC) + (size_t)(ch * 32 + g) * 128;
                *(f32x2*)(sl + 2 * x) = (f32x2){endr[0], endr[1]}; *(f32x2*)(sl + 64 + 2 * x) = (f32x2){endi[0], endi[1]}; }
            continue;
        }
        if (half == 0 && ch >= 511) {
            float* ore = ch == 511 ? a.out + O_PRE + g * 64 : a.out + O_SRE + (size_t)((ch - 512) * 32 + g) * 64;
            float* oim = ch == 511 ? a.out + O_PIM + g * 64 : a.out + O_SIM + (size_t)((ch - 512) * 32 + g) * 64;
            *(f32x2*)(ore + 2 * x) = (f32x2){endr[0], endr[1]}; *(f32x2*)(oim + 2 * x) = (f32x2){endi[0], endi[1]};
        }
#pragma unroll
        for (int r = 0; r < 16; ++r) { const int t = (r & 3) + 8 * (r >> 2) + 4 * half;
            *(LAS unsigned*)(sbuf + t * 272 + 4 * x) = cvt_pk_bf16(acc[0][r], acc[1][r]);
            *(LAS unsigned*)(sbuf + t * 272 + 128 + 4 * x) = cvt_pk_bf16(acc[2][r], acc[3][r]); }
        LDS_WAIT();
        f32x4 y[2] = {(f32x4){0.f, 0.f, 0.f, 0.f}, (f32x4){0.f, 0.f, 0.f, 0.f}};
#pragma unroll
        for (int ks = 0; ks < 4; ++ks) {
#pragma unroll
            for (int tt = 0; tt < 2; ++tt) { const bf16x8 sb = *(const LAS bf16x8*)(sbuf + (tt * 16 + l15) * 272 + (ks * 32 + q4 * 8) * 2); y[tt] = MFMA16(tc[ks], sb, y[tt]); } }
        LDS_WAIT();
#pragma unroll
        for (int tt = 0; tt < 2; ++tt) { const size_t off = (size_t)(m0 + tt * 16 + l15) * 512 + g * 16 + q4 * 4;
            const float o0 = gelu_t(y[tt][0] + dd[0] * bflo(uu[tt].x)), o1 = gelu_t(y[tt][1] + dd[1] * bfhi(uu[tt].x)), o2 = gelu_t(y[tt][2] + dd[2] * bflo(uu[tt].y)), o3 = gelu_t(y[tt][3] + dd[3] * bfhi(uu[tt].y));
            v2u w; w.x = cvt_pk_bf16(o0, o1); w.y = cvt_pk_bf16(o2, o3); *(v2u*)(YS + off) = w; }
    }
}

__device__ __forceinline__ void s5_chunk_scan(const Args& a, int g, LAS unsigned char* lds, int tid) {
    const int n = tid & 63, seg = tid >> 6;
    const float* TP = (const float*)(a.ws + WS_TP) + (size_t)(g * 64 + n) * 4;
    const float pr = TP[0], pi = TP[1], qr = TP[2], qi = TP[3];
    const float* sl = (const float*)(a.ws + WS_SLOC) + (size_t)(seg * 64) * 4096 + g * 128 + n;
    float* st = (float*)(a.ws + WS_SST) + (size_t)(seg * 64) * 4096 + g * 128 + n;
    float vr = 0.f, vi = 0.f;
    for (int hb = 0; hb < 2; ++hb) {
        float lre[32], lim[32];
        const float* sp = sl + (size_t)hb * 32 * 4096;
#pragma unroll
        for (int k = 0; k < 32; ++k) { lre[k] = sp[(size_t)k * 4096]; lim[k] = sp[(size_t)k * 4096 + 64]; }
#pragma unroll
        for (int k = 0; k < 32; ++k) { const float t = pr * vr - pi * vi + lre[k]; vi = pr * vi + pi * vr + lim[k]; vr = t; }
    }
    LAS f32x2* agg = (LAS f32x2*)lds;
    agg[seg * 64 + n] = (f32x2){vr, vi};
    __syncthreads();
    float cr = 0.f, ci = 0.f;
    for (int s = 0; s < seg; ++s) { const f32x2 ag = agg[s * 64 + n]; const float t = qr * cr - qi * ci + ag.x; ci = qr * ci + qi * cr + ag.y; cr = t; }
    vr = cr; vi = ci;
    for (int hb = 0; hb < 2; ++hb) {
        float lre[32], lim[32];
        const float* sp = sl + (size_t)hb * 32 * 4096; float* dp = st + (size_t)hb * 32 * 4096;
#pragma unroll
        for (int k = 0; k < 32; ++k) { lre[k] = sp[(size_t)k * 4096]; lim[k] = sp[(size_t)k * 4096 + 64]; }
#pragma unroll
        for (int k = 0; k < 32; ++k) { dp[(size_t)k * 4096] = vr; dp[(size_t)k * 4096 + 64] = vi;
            const float t = pr * vr - pi * vi + lre[k]; vi = pr * vi + pi * vr + lim[k]; vr = t; }
    }
    __syncthreads();
}

__device__ __forceinline__ void ln_stats(const Args& a, int vw, int NGW, int lane) {
    const bf16* GV = (const bf16*)(a.ws + WS_GV); f32x2* ST = (f32x2*)(a.ws + WS_STATS);
    constexpr int NB = 8;
    for (int mb = vw; mb < M; mb += NB * NGW) {
        v4u rw[NB];
#pragma unroll
        for (int b = 0; b < NB; ++b) { const int m = mb + b * NGW; if (m < M) rw[b] = *(const v4u*)(GV + (size_t)m * 512 + 8 * lane); }
#pragma unroll
        for (int b = 0; b < NB; ++b) { const int m = mb + b * NGW;
            if (m < M) { const unsigned wv[4] = {rw[b].x, rw[b].y, rw[b].z, rw[b].w};
                float s = 0.f, q = 0.f;
#pragma unroll
                for (int e = 0; e < 4; ++e) { const float d0 = bflo(wv[e]), d1 = bfhi(wv[e]); s += d0 + d1; q += d0 * d0 + d1 * d1; }
                s = wave_sum(s); q = wave_sum(q);
                const float mean = s * (1.0f / 512.0f), rstd = 1.0f / sqrtf(fmaxf(q * (1.0f / 512.0f) - mean * mean, 0.f) + EPS);
                if (lane == 0) ST[m] = (f32x2){mean, rstd}; } }
    }
}
template <int NKS>
__device__ __forceinline__ void gmlp_tile(const float* W, const float* BS, LAS unsigned char* vt, const bf16* UG, bf16* CAT, int m0, int h, int itile, int lane) {
    constexpr int VP = 272;
    const int half = lane >> 5, x = lane & 31, i = 32 * itile + x;
    bf16x8 bfr[NKS];
#pragma unroll
    for (int ks = 0; ks < NKS; ++ks) { const float* wp = W + (size_t)i * 128 + 16 * ks + 8 * half;
        const f32x4 w0 = *(const f32x4*)wp, w1 = *(const f32x4*)(wp + 4);
        v4u wb; wb.x = cvt_pk_bf16(w0.x, w0.y); wb.y = cvt_pk_bf16(w0.z, w0.w); wb.z = cvt_pk_bf16(w1.x, w1.y); wb.w = cvt_pk_bf16(w1.z, w1.w);
        bfr[ks] = __builtin_bit_cast(bf16x8, wb); }
    const float bsv = BS[i];
    v2u uu[2][4];
#pragma unroll
    for (int ct = 0; ct < 2; ++ct)
#pragma unroll
        for (int rq = 0; rq < 4; ++rq) uu[ct][rq] = *(const v2u*)(UG + (size_t)(m0 + i) * 512 + h * 64 + 32 * ct + 8 * rq + 4 * half);
    f32x16 acc[2];
#pragma unroll
    for (int r = 0; r < 16; ++r) { acc[0][r] = 0.f; acc[1][r] = 0.f; }
#pragma unroll
    for (int ks = 0; ks < NKS; ++ks)
#pragma unroll
        for (int ct = 0; ct < 2; ++ct) { const bf16x8 af = *(const LAS bf16x8*)(vt + (32 * ct + x) * VP + (16 * ks + 8 * half) * 2); acc[ct] = MFMA32(af, bfr[ks], acc[ct]); }
#pragma unroll
    for (int ct = 0; ct < 2; ++ct)
#pragma unroll
        for (int rq = 0; rq < 4; ++rq) { const int c0 = h * 64 + 32 * ct + 8 * rq + 4 * half; const v2u u2 = uu[ct][rq];
            const float o0 = bflo(u2.x) * (acc[ct][4 * rq + 0] + bsv), o1 = bfhi(u2.x) * (acc[ct][4 * rq + 1] + bsv), o2 = bflo(u2.y) * (acc[ct][4 * rq + 2] + bsv), o3 = bfhi(u2.y) * (acc[ct][4 * rq + 3] + bsv);
            v2u w; w.x = cvt_pk_bf16(o0, o1); w.y = cvt_pk_bf16(o2, o3);
            *(v2u*)(CAT + (size_t)(m0 + i) * 1024 + 512 + c0) = w; }
}
__device__ __forceinline__ void gmlp_item(const Args& a, int ck, int h, LAS unsigned char* vt, int lane) {
    constexpr int VP = 272;
    const int m0 = ck < 128 ? ck * 128 : SEQ + (ck - 128) * 32, ntok = ck < 128 ? 128 : 32;
    const bf16* GV = (const bf16*)(a.ws + WS_GV); const bf16* UG = (const bf16*)(a.ws + WS_UG); bf16* CAT = (bf16*)(a.ws + WS_CAT);
    const f32x2* ST = (const f32x2*)(a.ws + WS_STATS);
    const float* lg = a.in[21] + h * 64; const float* lb = a.in[22] + h * 64;
#pragma unroll
    for (int tp = 0; tp < 2; ++tp) { const int tk = lane + 64 * tp;
        if (tk < ntok) {
            const f32x2 st = ST[m0 + tk]; const float mean = st.x, rstd = st.y;
            const bf16* src = GV + (size_t)(m0 + tk) * 512 + h * 64;
            float* vout = (ck >= 128) ? a.out + O_V + (size_t)((ck - 128) * 32 + tk) * 512 + h * 64 : nullptr;
            v4u rw[8];
#pragma unroll
            for (int i = 0; i < 8; ++i) rw[i] = *(const v4u*)(src + 8 * i);
#pragma unroll
            for (int i = 0; i < 8; ++i) { const unsigned wv[4] = {rw[i].x, rw[i].y, rw[i].z, rw[i].w};
                const f32x4 g0 = *(const f32x4*)(lg + 8 * i), g1 = *(const f32x4*)(lg + 8 * i + 4), b0 = *(const f32x4*)(lb + 8 * i), b1 = *(const f32x4*)(lb + 8 * i + 4);
                const float gq[8] = {g0.x, g0.y, g0.z, g0.w, g1.x, g1.y, g1.z, g1.w}, bq[8] = {b0.x, b0.y, b0.z, b0.w, b1.x, b1.y, b1.z, b1.w};
                float vv[8];
#pragma unroll
                for (int e = 0; e < 4; ++e) { vv[2 * e] = (bflo(wv[e]) - mean) * rstd * gq[2 * e] + bq[2 * e]; vv[2 * e + 1] = (bfhi(wv[e]) - mean) * rstd * gq[2 * e + 1] + bq[2 * e + 1]; }
                if (vout) { *(f32x4*)(vout + 8 * i) = (f32x4){vv[0], vv[1], vv[2], vv[3]}; *(f32x4*)(vout + 8 * i + 4) = (f32x4){vv[4], vv[5], vv[6], vv[7]}; }
#pragma unroll
                for (int e = 0; e < 8; ++e) *(LAS unsigned short*)(vt + (8 * i + e) * VP + tk * 2) = (unsigned short)(cvt_pk_bf16(vv[e], 0.f) & 0xffffu);
            }
        }
    }
    LDS_WAIT();
    const float* W = a.in[23] + (size_t)h * 128 * 128; const float* BS = a.in[24] + h * 128;
    if (ntok == 128) {
        gmlp_tile<4>(W, BS, vt, UG, CAT, m0, h, 0, lane); gmlp_tile<4>(W, BS, vt, UG, CAT, m0, h, 1, lane);
        gmlp_tile<8>(W, BS, vt, UG, CAT, m0, h, 2, lane); gmlp_tile<8>(W, BS, vt, UG, CAT, m0, h, 3, lane);
    } else gmlp_tile<2>(W, BS, vt, UG, CAT, m0, h, 0, lane);
    LDS_WAIT();
}

__device__ __forceinline__ void skinny_sample(const bf16* A, const bf16* WT, int K, const float* base, const float* gate, float* out, int unit, int wave, int lane) {
    const int rh = unit >> 6, cs = unit & 63, l15 = lane & 15, q4 = lane >> 4;
    const int row = rh * 128 + wave * 16 + l15, c0 = cs * 16;
    const bf16* ap = A + (size_t)row * K + q4 * 8; const bf16* bp = WT + (size_t)(c0 + l15) * K + q4 * 8;
    f32x4 acc0 = (f32x4){0.f, 0.f, 0.f, 0.f}, acc1 = acc0;
#pragma unroll 4
    for (int k = 0; k < K; k += 64) {
        const bf16x8 a0 = *(const bf16x8*)(ap + k), b0 = *(const bf16x8*)(bp + k), a1 = *(const bf16x8*)(ap + k + 32), b1 = *(const bf16x8*)(bp + k + 32);
        acc0 = MFMA16(b0, a0, acc0); acc1 = MFMA16(b1, a1, acc1); }
    const f32x4 acc = acc0 + acc1;
    const int mr = 1 + (row >> 5), c = c0 + q4 * 4;
    const f32x4 b = *(const f32x4*)(base + (size_t)row * D + c), g = *(const f32x4*)(gate + (size_t)mr * NMOD + c);
    *(f32x4*)(out + (size_t)row * D + c) = b + g * acc;
}

__global__ void __launch_bounds__(512, 2) mega(Args a) {
    extern __shared__ __attribute__((aligned(16))) unsigned char lds_raw[];
    LAS unsigned char* lds = (LAS unsigned char*)lds_raw;
    cg::grid_group grid = cg::this_grid();
    const int tid = threadIdx.x, lane = tid & 63, wave = __builtin_amdgcn_readfirstlane(tid >> 6);
    const int G = gridDim.x, bx = blockIdx.x;
    const int vw = wave * G + bx, NGW = G * 8;
    const int lo = a.ph_lo, hi = a.ph_hi;
    volatile LAS unsigned* xst = (volatile LAS unsigned*)(lds + LDS_BYTES - 64);
    if (tid < 16) xst[tid] = 0u;
    __syncthreads();
    const XcdBarrier xbar = xcd_barrier_post((unsigned*)a.ws, xst);
    if (hi > 1000) grid.sync();
#ifndef REPMASK
#define REPMASK 0
#endif
#ifndef PHMASK
#define PHMASK 0xfff
#endif
#define IN(k) ((((PHMASK) >> (k)) & 1) && lo <= (k) && (k) < hi)
#define SEAM(k) do { if (IN(k) && IN((k) + 1)) xcd_barrier(xbar); } while (0)

    if (IN(0)) for (int rep = 0; rep <= ((REPMASK >> 0) & 1); ++rep) { if (rep) xcd_barrier(xbar); p0_prologue(a, lds, vw, NGW, wave, lane); }
    SEAM(0);
    if (IN(1)) for (int rep = 0; rep <= ((REPMASK >> 1) & 1); ++rep) { if (rep) xcd_barrier(xbar);
        float* modf = (float*)(a.ws + WS_MODF); const float* modp = (const float*)(a.ws + WS_MODP);
        for (int i = bx * 512 + tid; i < 9 * NMOD; i += G * 512) { float s = a.in[9][i % NMOD];
#pragma unroll
            for (int ks = 0; ks < NKS; ++ks) s += modp[(size_t)ks * 9 * NMOD + i];
            modf[i] = s; }
        { LAS float* lco = (LAS float*)lds;
            for (int k = tid; k < 2 * D; k += 512) { const int off = k < D ? D + k : k - D;
                float sv = a.in[9][off];
#pragma unroll
                for (int ks = 0; ks < NKS; ++ks) sv += modp[(size_t)ks * 9 * NMOD + off];
                lco[k] = sv; }
            __syncthreads();
            hprep<0>(a, vw, NGW, lane, lco); __syncthreads(); }
    }
    SEAM(1);
    if (IN(2)) for (int rep = 0; rep <= ((REPMASK >> 2) & 1); ++rep) { if (rep) xcd_barrier(xbar);
        pg8::Gemm g{(const bf16*)(a.ws + WS_H), (const bf16*)(a.ws + WS_WIN), M, INW, D}; pg8::StaticOrder S; S.init(M, INW, G, bx);
        EpiIn E{(bf16*)(a.ws + WS_ZS5), (bf16*)(a.ws + WS_UG), (bf16*)(a.ws + WS_GV)};
        pg8::gemm_phase<EpiIn, pg8::StaticOrder, true, true>(lds, g, S, E);
    }
    SEAM(2);
    if (IN(3)) for (int rep = 0; rep <= ((REPMASK >> 3) & 1); ++rep) { if (rep) xcd_barrier(xbar);
        ln_stats(a, vw, NGW, lane);
        s5_phase<false>(a, lds + wave * 8704, vw, NGW, lane, 512 * 32);
    }
    SEAM(3);
    if (IN(4)) for (int rep = 0; rep <= ((REPMASK >> 4) & 1); ++rep) { if (rep) xcd_barrier(xbar);
        for (int g = bx; g < 32; g += G) s5_chunk_scan(a, g, lds, tid);
        { const int gb = G > 64 ? 32 : 0; if (bx >= gb) for (int it = wave * (G - gb) + (bx - gb); it < 136 * 8; it += (G - gb) * 8) gmlp_item(a, it >> 3, it & 7, lds + wave * 17408, lane); }
    }
    SEAM(4);
    if (IN(5)) for (int rep = 0; rep <= ((REPMASK >> 5) & 1); ++rep) { if (rep) xcd_barrier(xbar);
        s5_phase<true>(a, lds + wave * 8704, vw, NGW, lane, NCH * 32);
    }
    SEAM(5);
    if (IN(6)) for (int rep = 0; rep <= ((REPMASK >> 6) & 1); ++rep) { if (rep) xcd_barrier(xbar);
        pg8::Gemm g{(const bf16*)(a.ws + WS_YS), (const bf16*)(a.ws + WS_WGLU), M, 512, 512}; pg8::StaticOrder S; S.init(M, 512, G, bx);
        EpiGlu E{(const bf16*)(a.ws + WS_YS), (bf16*)(a.ws + WS_CAT), a.in[20]};
        pg8::gemm_phase<EpiGlu, pg8::StaticOrder, true, true>(lds, g, S, E);
    }
    SEAM(6);
    if (IN(7)) for (int rep = 0; rep <= ((REPMASK >> 7) & 1); ++rep) { if (rep) xcd_barrier(xbar);
        pg8::Gemm g{(const bf16*)(a.ws + WS_CAT), (const bf16*)(a.ws + WS_WOUT), SEQ, D, D}; pg8::StaticOrder S; S.init(SEQ, D, G, bx);
        EpiRes E{a.in[0], a.in[1], (const float*)(a.ws + WS_MODF) + 2 * D, (float*)(a.ws + WS_X1)};
        pg8::gemm_phase<EpiRes, pg8::StaticOrder, true, true>(lds, g, S, E);
        for (int u = bx; u < 128; u += G) skinny_sample((const bf16*)(a.ws + WS_CAT) + (size_t)SEQ * D, (const bf16*)(a.ws + WS_WOUT), D, a.in[1], (const float*)(a.ws + WS_MODF) + 2 * D, (float*)(a.ws + WS_X1) + (size_t)SEQ * D, u, wave, lane);
    }
    SEAM(7);
    if (IN(8)) for (int rep = 0; rep <= ((REPMASK >> 8) & 1); ++rep) { if (rep) xcd_barrier(xbar); hprep<1>(a, vw, NGW, lane, (LAS float*)lds); }
    SEAM(8);
    if (IN(9)) for (int rep = 0; rep <= ((REPMASK >> 9) & 1); ++rep) { if (rep) xcd_barrier(xbar);
        pg8::Gemm g{(const bf16*)(a.ws + WS_H), (const bf16*)(a.ws + WS_WGU), M, GUW, D}; pg8::StaticOrder S; S.init(M, GUW, G, bx);
        EpiGU E{(bf16*)(a.ws + WS_HID)};
        pg8::gemm_phase<EpiGU, pg8::StaticOrder, true, true>(lds, g, S, E);
    }
    SEAM(9);
    if (IN(10)) for (int rep = 0; rep <= ((REPMASK >> 10) & 1); ++rep) { if (rep) xcd_barrier(xbar);
        pg8::Gemm g{(const bf16*)(a.ws + WS_HID), (const bf16*)(a.ws + WS_WD), SEQ, D, DFF}; pg8::StaticOrder S; S.init(SEQ, D, G, bx);
        const float* x1 = (const float*)(a.ws + WS_X1);
        EpiRes E{x1, x1 + (size_t)SEQ * D, (const float*)(a.ws + WS_MODF) + 5 * D, a.out};
        pg8::gemm_phase<EpiRes, pg8::StaticOrder, true, true>(lds, g, S, E);
        for (int u = bx; u < 128; u += G) skinny_sample((const bf16*)(a.ws + WS_HID) + (size_t)SEQ * DFF, (const bf16*)(a.ws + WS_WD), DFF, x1 + (size_t)SEQ * D, (const float*)(a.ws + WS_MODF) + 5 * D, a.out + (size_t)SEQ * D, u, wave, lane);
    }
    SEAM(10);
    if (IN(11)) for (int rep = 0; rep <= ((REPMASK >> 11) & 1); ++rep) { if (rep) xcd_barrier(xbar);
        const float* fg = a.in[28];
        f32x4 gg[4];
#pragma unroll
        for (int j = 0; j < 4; ++j) gg[j] = *(const f32x4*)(fg + 4 * lane + 256 * j);
        constexpr int NB = 4;
        for (int mb = vw; mb < M; mb += NB * NGW) {
            f32x4 v[NB][4];
#pragma unroll
            for (int b = 0; b < NB; ++b) { const int m = mb + b * NGW;
                if (m < M) {
#pragma unroll
                    for (int j = 0; j < 4; ++j) v[b][j] = *(const f32x4*)(a.out + (size_t)m * D + 4 * lane + 256 * j); } }
#pragma unroll
            for (int b = 0; b < NB; ++b) { const int m = mb + b * NGW;
                if (m < M) { float ss = 0.f;
#pragma unroll
                    for (int j = 0; j < 4; ++j) ss += (v[b][j].x * v[b][j].x + v[b][j].y * v[b][j].y) + (v[b][j].z * v[b][j].z + v[b][j].w * v[b][j].w);
                    const float rstd = 1.0f / sqrtf(wave_sum(ss) * (1.0f / D) + EPS);
#pragma unroll
                    for (int j = 0; j < 4; ++j) *(f32x4*)(a.out + (size_t)m * D + 4 * lane + 256 * j) = v[b][j] * rstd * gg[j]; } }
        }
    }
#undef IN
#undef SEAM
}

#ifndef MK_PER_PHASE
#define MK_PER_PHASE 0
#endif
extern "C" void kernel_launch(void* const* d_in, const int* in_sizes, int n_in, void* d_out, int out_size, void* d_ws, size_t ws_size, hipStream_t stream) {
    static int grid = 0;
    if (grid == 0) {
        int dev = 0, cus = 0, per_cu = 0;
        if (n_in != 29 || ws_size < WS_END) { fprintf(stderr, "kernel_launch: unexpected n_in %d / ws %zu\n", n_in, ws_size); grid = -1; return; }
        hipGetDevice(&dev); hipDeviceGetAttribute(&cus, hipDeviceAttributeMultiprocessorCount, dev);
        hipFuncSetAttribute((const void*)mega, hipFuncAttributeMaxDynamicSharedMemorySize, LDS_BYTES);
        hipOccupancyMaxActiveBlocksPerMultiprocessor(&per_cu, (const void*)mega, 512, LDS_BYTES);
        if (per_cu < 1) { fprintf(stderr, "kernel_launch: occupancy query says %d blocks/CU\n", per_cu); per_cu = 1; }
        (void)hipGetLastError();
        grid = cus * 1;
    }
    if (grid < 0) return;
    Args a{};
    for (int i = 0; i < 29; ++i) a.in[i] = (const float*)d_in[i];
    a.out = (float*)d_out; a.ws = (unsigned char*)d_ws;
    a.ph_lo = 0; a.ph_hi = NPH;
    if (hipMemsetAsync(d_ws, 0, 16384, stream) != hipSuccess) { fprintf(stderr, "kernel_launch: memset of the barrier words failed\n"); return; }
    void* args[] = {&a};
    hipError_t e = hipLaunchCooperativeKernel((const void*)mega, dim3(grid), dim3(512), args, LDS_BYTES, stream);
    if (e != hipSuccess) fprintf(stderr, "cooperative launch failed: %s (grid %d)\n", hipGetErrorString(e), grid);
}
```
